# Optimizing an MI355X kernel written in HIP

```python
import jax, jax.numpy as jnp
from jax import lax
import numpy as np

D_MODEL = 4096
BATCH = 8
SEQ = 2048
DEPTH = 1
DEC_BATCH = 1
DEC_SEQ = 8192
PAST_LEN = 128

HEAD_DIM = 128
N_HEADS = D_MODEL // HEAD_DIM
N_KV_HEADS = N_HEADS // 4
GQA_GROUP = N_HEADS // N_KV_HEADS
Q_DIM = N_HEADS * HEAD_DIM
KV_DIM = N_KV_HEADS * HEAD_DIM
CONV_DIM = D_MODEL
CONV_WIDTH = 3
D_FF = 11008
GRID_W = 64
Q_BLOCK = 128
ROPE_THETA = 10000.0
AXIAL_DIM = HEAD_DIM // 2
NORM_EPS = 1e-6
IN_SIZES = [Q_DIM, KV_DIM, KV_DIM, CONV_DIM, CONV_DIM, CONV_DIM, D_MODEL, D_MODEL]
IN_COLS = int(sum(IN_SIZES))
IN_SPLITS = [int(v) for v in np.cumsum(IN_SIZES)[:-1]]

kernel_name = 'hybrid_gqa_shortconv_convffn_encoder'


def rmsnorm(x, g):
    xf = x.astype(jnp.float32)
    y = xf * lax.rsqrt(jnp.mean(xf * xf, axis=-1, keepdims=True) + NORM_EPS)
    return (y * g.astype(jnp.float32)).astype(x.dtype)


def dwconv3(x, w, b):
    xp = jnp.pad(x, ((0, 0), (1, 1), (0, 0)))
    return xp[:, :-2] * w[0] + xp[:, 1:-1] * w[1] + xp[:, 2:] * w[2] + b


def axial_angles(seq_len, dtype):
    n_rows = seq_len // GRID_W
    rows = jnp.repeat(jnp.arange(n_rows, dtype=jnp.int32), GRID_W)
    cols = jnp.arange(seq_len, dtype=jnp.int32) - rows * GRID_W
    inv_freq = ROPE_THETA ** (-jnp.arange(0, AXIAL_DIM, 2, dtype=jnp.float32) / AXIAL_DIM)
    ang_r = rows.astype(jnp.float32)[:, None] * inv_freq[None, :]
    ang_c = cols.astype(jnp.float32)[:, None] * inv_freq[None, :]
    f = lambda a: (jnp.cos(a)[:, None, :].astype(dtype), jnp.sin(a)[:, None, :].astype(dtype))
    return f(ang_r), f(ang_c)


def rope_half(x, cos, sin):
    h = x.shape[-1] // 2
    x1, x2 = x[..., :h], x[..., h:]
    return jnp.concatenate([x1 * cos - x2 * sin, x2 * cos + x1 * sin], axis=-1)


def axial_rope(x, rc, cc):
    return jnp.concatenate([rope_half(x[..., :AXIAL_DIM], *rc), rope_half(x[..., AXIAL_DIM:], *cc)], axis=-1)


def block_attention(q, k, v):
    b, s = q.shape[0], q.shape[1]
    nb = s // Q_BLOCK
    qb = q.reshape(b, nb, Q_BLOCK, N_KV_HEADS, GQA_GROUP, HEAD_DIM).transpose(1, 0, 2, 3, 4, 5)
    scale = HEAD_DIM ** -0.5

    def one_block(q_blk):
        sc = jnp.einsum('bqkgd,bskd->bkgqs', q_blk, k).astype(jnp.float32) * scale
        p = jax.nn.softmax(sc, axis=-1).astype(v.dtype)
        return jnp.einsum('bkgqs,bskd->bqkgd', p, v)

    out = lax.map(one_block, qb)
    return out.transpose(1, 0, 2, 3, 4, 5).reshape(b, s, Q_DIM)


def encoder_layer(h, c, w_ada, b_ada, g_mix_pre, w_in, g_q, g_k, conv_w, conv_b, w_o, g_mix_post,
                  g_ffn_pre, w_up, ffn_conv_w, ffn_conv_b, w_down, g_ffn_post):
    b, s, _ = h.shape
    mod = jnp.einsum('bd,de->be', jax.nn.silu(c), w_ada) + b_ada
    sh1, sc1, gt1, sh2, sc2, gt2 = jnp.split(mod[:, None, :], 6, axis=-1)

    u = rmsnorm(h, g_mix_pre) * (1 + sc1) + sh1
    proj = jnp.einsum('bsd,de->bse', u, w_in)
    q, k, v, gb, gc, xin, ga_attn, ga_conv = jnp.split(proj, IN_SPLITS, axis=-1)
    q = rmsnorm(q.reshape(b, s, N_HEADS, HEAD_DIM), g_q)
    k = rmsnorm(k.reshape(b, s, N_KV_HEADS, HEAD_DIM), g_k)
    v = v.reshape(b, s, N_KV_HEADS, HEAD_DIM)
    rc, cc = axial_angles(s, h.dtype)
    q = axial_rope(q, rc, cc)
    k = axial_rope(k, rc, cc)
    attn = block_attention(q, k, v)
    conv = gb * dwconv3(gc * xin, conv_w, conv_b)
    merged = jax.nn.sigmoid(ga_attn) * attn + jax.nn.sigmoid(ga_conv) * conv
    out = jnp.einsum('bsd,de->bse', merged, w_o)
    h = h + gt1 * rmsnorm(out, g_mix_post)

    u2 = rmsnorm(h, g_ffn_pre) * (1 + sc2) + sh2
    z = dwconv3(jnp.einsum('bsd,df->bsf', u2, w_up), ffn_conv_w, ffn_conv_b)
    za, zb = jnp.split(z, 2, axis=-1)
    y = jnp.einsum('bsf,fd->bsd', jax.nn.silu(za) * zb, w_down)
    h = h + gt2 * rmsnorm(y, g_ffn_post)
    return h


def setup_inputs(seed: int = 0) -> dict:
    key = jax.random.key(seed)
    ks = jax.random.split(key, 20)
    nrm = lambda k, shape, s: jax.random.normal(k, shape, jnp.float32) * s
    gain = lambda k, shape: 1.0 + 0.05 * jax.random.normal(k, shape, jnp.float32)
    return {
        'x_prompt': nrm(ks[0], (BATCH, SEQ, D_MODEL), 1.0),
        'x_sample': nrm(ks[1], (DEC_BATCH, DEC_SEQ, D_MODEL), 1.0),
        'c_prompt': nrm(ks[2], (BATCH, D_MODEL), 1.0),
        'c_sample': nrm(ks[3], (DEC_BATCH, D_MODEL), 1.0),
        'w_ada': nrm(ks[4], (DEPTH, D_MODEL, 6 * D_MODEL), D_MODEL ** -0.5),
        'b_ada': nrm(ks[5], (DEPTH, 6 * D_MODEL), 0.02),
        'g_mix_pre': gain(ks[6], (DEPTH, D_MODEL)),
        'w_in': nrm(ks[7], (DEPTH, D_MODEL, IN_COLS), D_MODEL ** -0.5),
        'g_q': gain(ks[8], (DEPTH, HEAD_DIM)),
        'g_k': gain(ks[9], (DEPTH, HEAD_DIM)),
        'conv_w': nrm(ks[10], (DEPTH, CONV_WIDTH, CONV_DIM), CONV_WIDTH ** -0.5),
        'conv_b': nrm(ks[11], (DEPTH, CONV_DIM), 0.02),
        'w_o': nrm(ks[12], (DEPTH, D_MODEL, D_MODEL), D_MODEL ** -0.5),
        'g_mix_post': gain(ks[13], (DEPTH, D_MODEL)),
        'g_ffn_pre': gain(ks[14], (DEPTH, D_MODEL)),
        'w_up': nrm(ks[15], (DEPTH, D_MODEL, 2 * D_FF), D_MODEL ** -0.5),
        'ffn_conv_w': nrm(ks[16], (DEPTH, CONV_WIDTH, 2 * D_FF), CONV_WIDTH ** -0.5),
        'ffn_conv_b': nrm(ks[17], (DEPTH, 2 * D_FF), 0.02),
        'w_down': nrm(ks[18], (DEPTH, D_FF, D_MODEL), D_FF ** -0.5),
        'g_ffn_post': gain(ks[19], (DEPTH, D_MODEL)),
    }


def reference(x_prompt, x_sample, c_prompt, c_sample, w_ada, b_ada, g_mix_pre, w_in, g_q, g_k,
              conv_w, conv_b, w_o, g_mix_post, g_ffn_pre, w_up, ffn_conv_w, ffn_conv_b, w_down,
              g_ffn_post):
    hp = x_prompt
    hs = x_sample
    for l in range(DEPTH):
        p = (w_ada[l], b_ada[l], g_mix_pre[l], w_in[l], g_q[l], g_k[l], conv_w[l], conv_b[l], w_o[l],
             g_mix_post[l], g_ffn_pre[l], w_up[l], ffn_conv_w[l], ffn_conv_b[l], w_down[l], g_ffn_post[l])
        hp = encoder_layer(hp, c_prompt, *p)
        hs = encoder_layer(hs, c_sample, *p)
    y_prompt = hp
    y_sample = hs
    return (y_prompt, y_sample)
```

```cpp
#include <hip/hip_runtime.h>
#include <cstdio>
#include <cstdint>
#include <type_traits>

#ifndef MK_PER_PHASE
#define MK_PER_PHASE 0
#endif

#define GAS __attribute__((address_space(1)))
#define LAS __attribute__((address_space(3)))
typedef unsigned short bf16;
typedef short bf16x8 __attribute__((ext_vector_type(8)));
typedef short s16x4 __attribute__((ext_vector_type(4)));
typedef float f32x4 __attribute__((ext_vector_type(4)));
typedef float f32x16 __attribute__((ext_vector_type(16)));
typedef unsigned u32x4 __attribute__((ext_vector_type(4)));
typedef unsigned u32x2 __attribute__((ext_vector_type(2)));
typedef int i32x4 __attribute__((ext_vector_type(4)));

constexpr int DM = 4096, MP = 16384, MS = 8192, MROWS = MP + MS;
constexpr int SEQP = 2048, SEQS = 8192, NSEQ = 9;
constexpr int NIN = 26624, NUP = 22016, DFF = 11008, KVD = 1024;
constexpr int NINA = 8192, NINB = 18432;
#ifndef UP_T8
#define UP_T8 86
#endif
#ifndef UP_ROT
#define UP_ROT 1
#endif
constexpr int AMX_STRIDE = 8; constexpr float AMX_SAFETY = 1.2f;
constexpr int T8 = UP_T8, NT_UP = NUP / 256;
constexpr float NORM_EPS = 1e-6f;

constexpr size_t MiB = 1u << 20;
constexpr size_t WS_CTL = 0, WS_MOD = 1 * MiB, ZERO_BYTES = 2 * MiB;
constexpr size_t WS_CAMAX = 768 * 1024;
constexpr size_t WS_ROPE = 2 * MiB;
constexpr size_t WS_CAMAX3 = 512 * 1024;
constexpr size_t WS_CAMAX2 = WS_MOD + (size_t)NSEQ * 6 * DM * 4;
constexpr size_t WS_SWP = WS_ROPE + 786432, WS_SU = WS_ROPE + 131072, WS_SU2 = WS_ROPE + 262144, WS_SWPU = WS_ROPE + 393216, WS_SWD = WS_ROPE + 524288, WS_SA = WS_ROPE + 655360;
constexpr size_t WS_W8 = 99 * MiB;
constexpr size_t WS_WIN = 3 * MiB, WS_WO = 211 * MiB, WS_WUP = 243 * MiB, WS_WDN = 415 * MiB;
constexpr size_t WS_ACT8 = 3 * MiB;
constexpr size_t WS_U = 501 * MiB;
constexpr size_t WS_BIG = 693 * MiB;
constexpr size_t WS_Q = WS_BIG, WS_K = WS_BIG + 192 * MiB, WS_V = WS_BIG + 240 * MiB, WS_P = WS_BIG + 288 * MiB, WS_GBS = WS_BIG + 480 * MiB, WS_SGA = WS_BIG + 672 * MiB;
constexpr size_t WS_V8T = WS_K + 24 * MiB;
constexpr size_t WS_OUT = WS_P;
constexpr size_t WS_ACT = WS_BIG, WS_SB = WS_BIG + 516 * MiB, WS_Y = WS_BIG + 600 * MiB, WS_U28 = WS_Y;
constexpr size_t WS_END = WS_BIG + 864 * MiB;
static_assert(T8 == NT_UP, "h1 lives (bf16) where the bf16 copy of u2 would go: all up-projection tiles must be int8");
static_assert(WS_ACT8 + (size_t)MROWS * DFF <= WS_WDN && WS_SA + (size_t)MROWS * 4 <= WS_WIN && WS_CAMAX2 + (size_t)NUP * 4 <= ZERO_BYTES && WS_CAMAX3 + (size_t)DM * 4 <= WS_CAMAX && WS_CAMAX + (size_t)NINB * 4 <= WS_MOD && WS_SWP + (size_t)NINB * 4 <= WS_WIN && WS_SWPU + (size_t)NUP * 4 <= WS_WIN && WS_WIN + (size_t)NINA * DM * 2 <= WS_W8 && WS_W8 + (size_t)NINB * DM <= WS_WO && WS_WO + (size_t)DM * DM * 2 <= WS_WUP && WS_WUP + (size_t)NUP * DM * 2 <= WS_WDN && WS_WDN + (size_t)DM * DFF * 2 <= WS_U, "weights map");
static_assert(WS_U + (size_t)MROWS * DM * 2 <= WS_BIG && WS_ACT + (size_t)MROWS * DFF * 2 <= WS_SB && WS_SB + (size_t)(MROWS / 128) * 4 * NUP * 4 <= WS_Y && WS_Y + (size_t)MROWS * DM * 2 <= WS_END && WS_SGA + (size_t)MROWS * DM * 2 <= WS_END, "act map");
constexpr size_t OUT_U8 = 0;
constexpr int CW_BAR = 4096;

constexpr int LDS_BYTES = 147456;
constexpr int XS_OFF = 135168;
constexpr int ATT_SCR_OFF = 133120;
constexpr int LDSCTL_OFF = 146432;
constexpr int TR_SCR = 16640;

namespace pg8 {
#define PG8_LAS __attribute__((address_space(3)))
typedef unsigned short bf16_t;
constexpr int BM = 256, BK = 64, HALF = 128, HTB = HALF * BK * 2, STAGE_BYTES = 8 * HTB, NXCD = 8, WGM = 8;
__host__ __device__ __forceinline__ int lds_byte(int r, int c) { const int st = (r >> 4) * 2 + (c >> 5), rr = r & 15, cc = c & 31, ob = rr * 64 + cc * 2; return st * 1024 + (ob ^ (((ob >> 9) & 1) << 5)); }
__host__ __device__ __forceinline__ void stage_rc(int b, int& R, int& C) { const int st = b / 1024, sb = b % 1024, swz = sb ^ (((sb >> 9) & 1) << 5); R = (st >> 1) * 16 + swz / 64; C = (st & 1) * 32 + (swz % 64) / 2; }
__host__ __device__ __forceinline__ int perm32(int rho) { const int n = rho >> 4, i = rho & 15; return 8 * (i >> 2) + 4 * n + (i & 3); }
struct Unit { int pm, pn; };
struct Gemm { const bf16_t* A; const bf16_t* Bt; int M, N, K; };
struct StaticOrder {
    int nM, nN, nwg, G, c;
    __host__ __device__ void init(int M, int N, int G_, int c_) { nM = M / BM; nN = N / BM; nwg = nM * nN; G = G_; c = c_; }
    __host__ __device__ bool next(int i, Unit& u) const {
        const long L = (long)i * G + c; if (L >= nwg) return false;
        int wgid = (int)L; { const int q = nwg / NXCD, r = nwg % NXCD, xcd = wgid % NXCD, off = wgid / NXCD; wgid = (xcd < r ? xcd * (q + 1) : r * (q + 1) + (xcd - r) * q) + off; }
        const int nig = WGM * nN, gid = wgid / nig, fm = gid * WGM, gsz = (nM - fm) < WGM ? (nM - fm) : WGM;
        u.pm = fm + ((wgid % nig) % gsz); u.pn = (wgid % nig) / gsz; return true;
    }
    __device__ __forceinline__ void a_ready(const Unit&) const {}
    __device__ __forceinline__ void done(const Unit&) const {}
};
__device__ __forceinline__ unsigned cvt_pk_bf16(float lo, float hi) { unsigned r; asm volatile("v_cvt_pk_bf16_f32 %0, %1, %2" : "=v"(r) : "v"(lo), "v"(hi)); return r; }
__device__ __forceinline__ float sigmoidf_(float x) { return __builtin_amdgcn_rcpf(1.0f + __builtin_amdgcn_exp2f(-1.4426950408889634f * x)); }
__device__ __forceinline__ f32x4 sig4(f32x4 v) { return (f32x4){sigmoidf_(v[0]), sigmoidf_(v[1]), sigmoidf_(v[2]), sigmoidf_(v[3])}; }
__device__ __forceinline__ u32x4 pack8(f32x4 v0, f32x4 v1) { u32x4 w; w.x = cvt_pk_bf16(v0[0], v0[1]); w.y = cvt_pk_bf16(v0[2], v0[3]); w.z = cvt_pk_bf16(v1[0], v1[1]); w.w = cvt_pk_bf16(v1[2], v1[3]); return w; }

__device__ __forceinline__ f32x4 mma_(bf16x8 b, bf16x8 a, f32x4 c) { return __builtin_amdgcn_mfma_f32_16x16x32_bf16(b, a, c, 0, 0, 0); }
__device__ __forceinline__ i32x4 mma_(bf16x8 b, bf16x8 a, i32x4 c) { return __builtin_amdgcn_mfma_i32_16x16x64_i8(__builtin_bit_cast(i32x4, b), __builtin_bit_cast(i32x4, a), c, 0, 0, 0); }
__device__ __forceinline__ f32x4 cvtf(i32x4 v) { return (f32x4){(float)v[0], (float)v[1], (float)v[2], (float)v[3]}; }
struct EpiI8Bf16 {
    static constexpr bool PERM = true, AFTER_DRAIN = false, ROWPERM = false, I8 = true; static constexpr int NS_MIN = 16;
    bf16_t* O; int ldc; const float* su; const float* sw;
    __device__ __forceinline__ void operator()(const i32x4 (&acc)[2][2][4][2], const Unit& u, int wr, int wc, int fr, int fq) const {
        const int row0 = u.pm * BM + wr * 64 + fr, col0 = u.pn * BM + wc * 32 + 8 * fq;
        f32x4 cs_[2][2];
#pragma unroll
        for (int bj = 0; bj < 2; ++bj)
#pragma unroll
            for (int n = 0; n < 2; ++n) cs_[bj][n] = *(const f32x4*)(sw + col0 + bj * HALF + 4 * n);
#pragma unroll
        for (int ai = 0; ai < 2; ++ai)
#pragma unroll
            for (int m = 0; m < 4; ++m) { const int row = row0 + ai * HALF + m * 16; const float rs = su[row]; bf16_t* rowp = O + (size_t)row * ldc + col0;
#pragma unroll
                for (int bj = 0; bj < 2; ++bj) *(u32x4*)(rowp + bj * HALF) = pack8(cvtf(acc[ai][bj][m][0]) * cs_[bj][0] * rs, cvtf(acc[ai][bj][m][1]) * cs_[bj][1] * rs); }
    }
};
struct EpiBf16 {
    static constexpr bool PERM = true, AFTER_DRAIN = false, ROWPERM = false, I8 = false; static constexpr int NS_MIN = 16;
    bf16_t* O; int ldc;
    __device__ __forceinline__ void operator()(const f32x4 (&acc)[2][2][4][2], const Unit& u, int wr, int wc, int fr, int fq) const {
        const int row0 = u.pm * BM + wr * 64 + fr, col0 = u.pn * BM + wc * 32 + 8 * fq;
#pragma unroll
        for (int ai = 0; ai < 2; ++ai)
#pragma unroll
            for (int m = 0; m < 4; ++m) { bf16_t* rowp = O + (size_t)(row0 + ai * HALF + m * 16) * ldc + col0;
#pragma unroll
                for (int bj = 0; bj < 2; ++bj) *(u32x4*)(rowp + bj * HALF) = pack8(acc[ai][bj][m][0], acc[ai][bj][m][1]); }
    }
};
__device__ __forceinline__ unsigned cvt4_fp8_(f32x4 v) { int w = __builtin_amdgcn_cvt_pk_fp8_f32(v[0], v[1], 0, false); return (unsigned)__builtin_amdgcn_cvt_pk_fp8_f32(v[2], v[3], w, true); }
struct EpiInB {
    static constexpr bool PERM = true, AFTER_DRAIN = false, ROWPERM = false, I8 = true; static constexpr int NS_MIN = 16;
    unsigned char* ws; const float *gq, *gk; PG8_LAS float* XS;
    __device__ __forceinline__ void operator()(const i32x4 (&acc)[2][2][4][2], const Unit& u, int wr, int wc, int fr_, int fq_) const {
        bf16_t* const Q = (bf16_t*)(ws + WS_Q); bf16_t* const Kb = (bf16_t*)(ws + WS_K); bf16_t* const Vb = (bf16_t*)(ws + WS_V); bf16_t* const SGA = (bf16_t*)(ws + WS_SGA); bf16_t* const GBS = (bf16_t*)(ws + WS_GBS);
        const float* const rope = (const float*)(ws + WS_ROPE); const float* const su = (const float*)(ws + WS_SU); const float* const sw = (const float*)(ws + WS_SWP);
        int ln = fq_ * 16 + fr_; asm volatile("" : "+v"(ln)); const int fr = ln & 15, fq = ln >> 4;
        const int row0 = u.pm * BM + wr * 64 + fr, cw = wc * 32 + 8 * fq, pn = u.pn;
        f32x4 cs_[2][2];
#pragma unroll
        for (int bj = 0; bj < 2; ++bj)
#pragma unroll
            for (int n = 0; n < 2; ++n) cs_[bj][n] = *(const f32x4*)(sw + pn * 256 + bj * HALF + cw + 4 * n);
        if (pn < 20) {
            const bool isq = pn < 16; signed char* base = isq ? (signed char*)Q + pn * 256 : (signed char*)Kb + (pn - 16) * 256; const int ldc = isq ? DM : KVD; const float* g = isq ? gq : gk;
            const int half = wc >> 1, i0 = 16 * (wc & 1) + 4 * fq, d1 = 64 * half + i0;
            const f32x4 g1 = *(const f32x4*)(g + d1), g2 = *(const f32x4*)(g + d1 + 32);
#pragma unroll
            for (int ai = 0; ai < 2; ++ai)
#pragma unroll
                for (int m = 0; m < 4; ++m) { const float rs = su[row0 + ai * HALF + m * 16];
#pragma unroll
                    for (int bj = 0; bj < 2; ++bj) { const f32x4 a = cvtf(acc[ai][bj][m][0]) * cs_[bj][0] * rs, b = cvtf(acc[ai][bj][m][1]) * cs_[bj][1] * rs;
                        float sq = (a[0] * a[0] + a[1] * a[1]) + (a[2] * a[2] + a[3] * a[3]) + (b[0] * b[0] + b[1] * b[1]) + (b[2] * b[2] + b[3] * b[3]);
                        sq += __shfl_xor(sq, 16); sq += __shfl_xor(sq, 32);
                        if (fq == 0) XS[(ai * HALF + wr * 64 + m * 16 + fr) * 8 + bj * 4 + wc] = sq; } }
            asm volatile("s_waitcnt lgkmcnt(0)" ::: "memory"); __builtin_amdgcn_s_barrier(); asm volatile("" ::: "memory");
#pragma unroll
            for (int ai = 0; ai < 2; ++ai)
#pragma unroll
                for (int m = 0; m < 4; ++m) { const int rit = ai * HALF + wr * 64 + m * 16 + fr, row = u.pm * BM + rit; const float rs = su[row];
                    const int t = row < MP ? (row & (SEQP - 1)) : (row - MP), pos = half ? (t & 63) : (t >> 6);
                    const f32x4 cs = *(const f32x4*)(rope + pos * 32 + i0), sn = *(const f32x4*)(rope + 4096 + pos * 32 + i0);
#pragma unroll
                    for (int bj = 0; bj < 2; ++bj) { const f32x4 ps = *(const PG8_LAS f32x4*)(XS + rit * 8 + bj * 4);
                        const float rstd = rs / sqrtf(((ps[0] + ps[1]) + (ps[2] + ps[3])) * (1.0f / 128.0f) + NORM_EPS);
                        const f32x4 y1 = cvtf(acc[ai][bj][m][0]) * cs_[bj][0] * rstd * g1, y2 = cvtf(acc[ai][bj][m][1]) * cs_[bj][1] * rstd * g2;
                        const f32x4 o1 = y1 * cs - y2 * sn, o2 = y2 * cs + y1 * sn;
                        signed char* op = base + (size_t)row * ldc + bj * HALF + d1;
                        *(unsigned*)op = cvt4_fp8_(o1); *(unsigned*)(op + 32) = cvt4_fp8_(o2); } }
        } else if (pn < 40) {
            const bool sg = pn >= 24; bf16_t* base = sg ? SGA + (pn - 24) * 256 : Vb + (pn - 20) * 256; const int ldc = sg ? DM : KVD;
#pragma unroll
            for (int ai = 0; ai < 2; ++ai)
#pragma unroll
                for (int m = 0; m < 4; ++m) { const int row = row0 + ai * HALF + m * 16; const float rs = su[row]; bf16_t* rowp = base + (size_t)row * ldc + cw;
#pragma unroll
                    for (int bj = 0; bj < 2; ++bj) { f32x4 v0 = cvtf(acc[ai][bj][m][0]) * cs_[bj][0] * rs, v1 = cvtf(acc[ai][bj][m][1]) * cs_[bj][1] * rs; if (sg) { v0 = sig4(v0); v1 = sig4(v1); } *(u32x4*)(rowp + bj * HALF) = pack8(v0, v1); } }
        } else {
            bf16_t* base = GBS + (pn - 40) * 128;
#pragma unroll
            for (int ai = 0; ai < 2; ++ai)
#pragma unroll
                for (int m = 0; m < 4; ++m) { const int row = row0 + ai * HALF + m * 16; const float rs = su[row];
                    const f32x4 v0 = cvtf(acc[ai][0][m][0]) * cs_[0][0] * rs, v1 = cvtf(acc[ai][0][m][1]) * cs_[0][1] * rs;
                    const f32x4 g0 = sig4(cvtf(acc[ai][1][m][0]) * cs_[1][0] * rs), g1 = sig4(cvtf(acc[ai][1][m][1]) * cs_[1][1] * rs);
                    *(u32x4*)(base + (size_t)row * DM + cw) = pack8(v0 * g0, v1 * g1); }
        }
    }
};
struct EpiInA {
    static constexpr bool PERM = true, AFTER_DRAIN = false, ROWPERM = false, I8 = false; static constexpr int NS_MIN = 8;
    bf16_t* P;
    __device__ __forceinline__ void operator()(const f32x4 (&acc)[2][2][4][2], const Unit& u, int wr, int wc, int fr, int fq) const {
        const int row0 = u.pm * BM + wr * 64 + fr, cw = wc * 32 + 8 * fq, pn = u.pn;
        bf16_t* base = P + pn * 128;
#pragma unroll
        for (int ai = 0; ai < 2; ++ai)
#pragma unroll
            for (int m = 0; m < 4; ++m) { bf16_t* rowp = base + (size_t)(row0 + ai * HALF + m * 16) * DM + cw;
                *(u32x4*)rowp = pack8(acc[ai][0][m][0] * acc[ai][1][m][0], acc[ai][0][m][1] * acc[ai][1][m][1]); }
    }
};

__device__ __forceinline__ f32x4 dpp_prev(f32x4 v) { f32x4 r;
#pragma unroll
    for (int e = 0; e < 4; ++e) { const float x = v[e]; r[e] = __int_as_float(__builtin_amdgcn_update_dpp(0, __float_as_int(x), 0x111, 0xf, 0xf, true)); }
    return r; }
__device__ __forceinline__ f32x4 dpp_next(f32x4 v) { f32x4 r;
#pragma unroll
    for (int e = 0; e < 4; ++e) { const float x = v[e]; r[e] = __int_as_float(__builtin_amdgcn_update_dpp(0, __float_as_int(x), 0x101, 0xf, 0xf, true)); }
    return r; }
template <bool I8_> struct EpiUp {
    static constexpr bool PERM = true, AFTER_DRAIN = false, ROWPERM = true, I8 = I8_; static constexpr int NS_MIN = 8;
    typedef typename std::conditional<I8_, i32x4, f32x4>::type acc_t;
    bf16_t* ACT; float* SB; const float* cw; const float* cb; const float* su; const float* sw; int pn0;
    static __device__ __forceinline__ f32x4 asf(f32x4 v) { return v; }
    static __device__ __forceinline__ f32x4 toa(f32x4 v) { return v; }
    __device__ __forceinline__ void operator()(acc_t (&accr)[2][2][4][2], const Unit& u, int wr, int wc, int fr_, int fq_) const {
        int ln = fq_ * 16 + fr_; asm volatile("" : "+v"(ln)); const int fr = ln & 15, fq = ln >> 4;
        const int pn = u.pn + pn0, cw8 = wc * 32 + 8 * fq, f0 = pn * 128 + cw8;
        const int strip = u.pm * 2 + wr; const size_t grow0 = (size_t)u.pm * BM + wr * 128 + fr * 8;
        float* sb = SB + (size_t)strip * 4 * NUP + (size_t)pn * 256 + cw8;
        f32x4 acc[2][2][4][2];
        if constexpr (I8_) {
            const f32x4 rsa = *(const f32x4*)(su + grow0), rsb = *(const f32x4*)(su + grow0 + 4);
#pragma unroll
            for (int j = 0; j < 8; ++j)
#pragma unroll
                for (int bj = 0; bj < 2; ++bj)
#pragma unroll
                    for (int n = 0; n < 2; ++n) { f32x4 t = cvtf(accr[j >> 2][bj][j & 3][n]) * (j < 4 ? rsa[j & 3] : rsb[j & 3]); asm volatile("" : "+v"(t)); acc[j >> 2][bj][j & 3][n] = t; }
        } else {
#pragma unroll
            for (int a = 0; a < 2; ++a)
#pragma unroll
                for (int b = 0; b < 2; ++b)
#pragma unroll
                    for (int m = 0; m < 4; ++m)
#pragma unroll
                        for (int n = 0; n < 2; ++n) acc[a][b][m][n] = accr[a][b][m][n];
        }
        f32x4 wv[2][2][4], csc[2][2];
#pragma unroll
        for (int bj = 0; bj < 2; ++bj)
#pragma unroll
            for (int n = 0; n < 2; ++n) { const int ci = bj * DFF + f0 + 4 * n;
                wv[bj][n][0] = *(const f32x4*)(cw + ci); wv[bj][n][1] = *(const f32x4*)(cw + NUP + ci); wv[bj][n][2] = *(const f32x4*)(cw + 2 * NUP + ci); wv[bj][n][3] = *(const f32x4*)(cb + ci);
                csc[bj][n] = I8_ ? *(const f32x4*)(sw + pn * 256 + bj * HALF + cw8 + 4 * n) : (f32x4){1.f, 1.f, 1.f, 1.f}; }
#pragma unroll
        for (int bj = 0; bj < 2; ++bj)
#pragma unroll
            for (int n = 0; n < 2; ++n) {
                if (fr == 0) *(f32x4*)(sb + bj * 128 + 4 * n) = acc[0][bj][0][n] * csc[bj][n];
                if (fr == 15) *(f32x4*)(sb + NUP + bj * 128 + 4 * n) = acc[1][bj][3][n] * csc[bj][n];
                const f32x4 w0 = wv[bj][n][0] * csc[bj][n], w1 = wv[bj][n][1] * csc[bj][n], w2 = wv[bj][n][2] * csc[bj][n], bb = wv[bj][n][3];
                f32x4 p = dpp_prev(acc[1][bj][3][n]); const f32x4 nx = dpp_next(acc[0][bj][0][n]);
#pragma unroll
                for (int j = 0; j < 8; ++j) { const f32x4 cur = acc[j >> 2][bj][j & 3][n]; const f32x4 nn = j < 7 ? acc[(j + 1) >> 2][bj][(j + 1) & 3][n] : nx;
                    acc[j >> 2][bj][j & 3][n] = w0 * p + (w1 * cur + (w2 * nn + bb)); p = cur; }
                if (fr == 0) *(f32x4*)(sb + 2 * NUP + bj * 128 + 4 * n) = acc[0][bj][0][n];
                if (fr == 15) *(f32x4*)(sb + 3 * NUP + bj * 128 + 4 * n) = acc[1][bj][3][n]; }
#pragma unroll
        for (int j = 0; j < 8; ++j) {
            f32x4 a0 = asf(acc[j >> 2][0][j & 3][0]), a1 = asf(acc[j >> 2][0][j & 3][1]); const f32x4 b0 = asf(acc[j >> 2][1][j & 3][0]), b1 = asf(acc[j >> 2][1][j & 3][1]);
            a0 = a0 * sig4(a0) * b0; a1 = a1 * sig4(a1) * b1;
            const bool skip = (j == 0 && fr == 0) || (j == 7 && fr == 15);
            if (!skip) __builtin_nontemporal_store(pack8(a0, a1), (u32x4*)(ACT + (grow0 + j) * DFF + f0));
            asm volatile("" ::: "memory"); __builtin_amdgcn_sched_barrier(0); }
    }
};

template <class Epi, class Sched, bool ALIGN_EPI = false, bool SP2 = false, bool BAL = false, bool REL = false>
__device__ __forceinline__ void gemm_phase(PG8_LAS unsigned char* lds, const Gemm g, const Sched& S, const Epi& E) {
    int tid_ = threadIdx.x; asm volatile("" : "+v"(tid_));
    const int tid = tid_, wid = __builtin_amdgcn_readfirstlane(tid >> 6), lane = tid & 63, wr = wid >> 2, wc = wid & 3, fr = lane & 15, fq = lane >> 4;
    const int K = g.K, nt = K / BK;
    unsigned voffA, voffB;
    { int R, C; stage_rc(tid * 16, R, C); const int Rb = Epi::PERM ? ((R & ~31) + perm32(R & 31)) : R;
        const int Ra = Epi::ROWPERM ? (128 * (R >> 6) + 8 * (R & 15) + ((R >> 4) & 3)) : R;
        voffA = (unsigned)(Ra * K + C) * 2u; voffB = (unsigned)(Rb * K + C) * 2u; }
    const size_t pstepB = (size_t)64 * K * 2, pstepA = Epi::ROWPERM ? (size_t)128 * K * 2 : pstepB;
    const size_t kstep = (size_t)(BK * 2);
    const size_t hstep = (size_t)HALF * K * 2;
    const size_t hstepA = Epi::ROWPERM ? (size_t)4 * K * 2 : hstep;
    const size_t tstep = 2 * hstep;
    const unsigned ldsw = (unsigned)wid * 1024u;
    const int aoff = lds_byte(wr * 64 + fr, fq * 8), boff = lds_byte(wc * 32 + fr, fq * 8);
#define PG8_SA(b, h) (((b) * 2 + (h)) * HTB)
#define PG8_SB(b, h) ((4 + (b) * 2 + (h)) * HTB)
#define PG8_STAGE(bufoff, gbase, voff) do { _Pragma("unroll") for (int _i = 0; _i < 2; ++_i) \
        __builtin_amdgcn_global_load_lds((const unsigned*)((const char*)(gbase) + (size_t)_i * p##voff + (voff)), (PG8_LAS unsigned*)(lds + (bufoff) + ldsw + _i * 8192), 16, 0, 0); } while (0)
#define pvoffA pstepA
#define pvoffB pstepB
#define PG8_LDA(dst, b, h) do { _Pragma("unroll") for (int m = 0; m < 4; ++m) _Pragma("unroll") for (int k = 0; k < 2; ++k) dst[m][k] = *(const PG8_LAS bf16x8*)(lds + PG8_SA(b, h) + aoff + m * 2048 + k * 1024); } while (0)
#define PG8_LDB(dst, b, h) do { _Pragma("unroll") for (int n = 0; n < 2; ++n) _Pragma("unroll") for (int k = 0; k < 2; ++k) dst[n][k] = *(const PG8_LAS bf16x8*)(lds + PG8_SB(b, h) + boff + n * 2048 + k * 1024); } while (0)
#define PG8_MMA(ai, bj, At, Bt) do { __builtin_amdgcn_s_setprio(1); _Pragma("unroll") for (int m = 0; m < 4; ++m) _Pragma("unroll") for (int n = 0; n < 2; ++n) _Pragma("unroll") for (int k = 0; k < 2; ++k) \
        acc[ai][bj][m][n] = mma_(Bt[n][k], At[m][k], acc[ai][bj][m][n]); __builtin_amdgcn_s_setprio(0); } while (0)
#define PG8_WAIT_V(n) asm volatile("s_waitcnt vmcnt(" #n ")" ::: "memory")
#define PG8_WAIT_VN(N) asm volatile("s_waitcnt vmcnt(%0)" :: "i"(N) : "memory")
#define PG8_WAIT_L(n) asm volatile("s_waitcnt lgkmcnt(" #n ")" ::: "memory")
#define PG8_BAR __builtin_amdgcn_s_barrier()
#define PG8_SCHED __builtin_amdgcn_sched_barrier(0)
    Unit cur, nxt; int ui = 0;
    if (!S.next(0, cur)) return;
    typedef typename std::conditional<Epi::I8, i32x4, f32x4>::type acc_t;
    acc_t acc[2][2][4][2];
#pragma unroll
    for (int a = 0; a < 2; ++a)
#pragma unroll
        for (int b = 0; b < 2; ++b)
#pragma unroll
            for (int m = 0; m < 4; ++m)
#pragma unroll
                for (int n = 0; n < 2; ++n) acc[a][b][m][n] = (acc_t){0, 0, 0, 0};
    bf16x8 At[4][2], B0[2][2], B1[2][2];
    const char* cA = (const char*)g.A + (size_t)cur.pm * tstep; const char* cB = (const char*)g.Bt + (size_t)cur.pn * tstep;
    S.a_ready(cur);
    if constexpr (SP2 && BAL && REL) {
        PG8_STAGE(PG8_SB(0, 0), cB, voffB); PG8_STAGE(PG8_SB(0, 1), cB + hstep, voffB); PG8_STAGE(PG8_SA(0, 0), cA, voffA); PG8_STAGE(PG8_SA(0, 1), cA + hstepA, voffA);
        PG8_STAGE(PG8_SB(1, 0), cB + kstep, voffB); PG8_STAGE(PG8_SB(1, 1), cB + hstep + kstep, voffB); PG8_STAGE(PG8_SA(1, 0), cA + kstep, voffA); PG8_STAGE(PG8_SA(1, 1), cA + kstep + hstepA, voffA);
        if (wr == 1) PG8_BAR;
        PG8_WAIT_V(0); PG8_BAR;
        PG8_BAR;
    } else if constexpr (SP2 && BAL) {
        PG8_STAGE(PG8_SB(0, 0), cB, voffB); PG8_STAGE(PG8_SB(0, 1), cB + hstep, voffB); PG8_STAGE(PG8_SA(0, 0), cA, voffA); PG8_STAGE(PG8_SA(0, 1), cA + hstepA, voffA);
        if (wr == 1) PG8_BAR;
        PG8_WAIT_V(2); PG8_BAR;
        PG8_STAGE(PG8_SB(1, 0), cB + kstep, voffB); PG8_STAGE(PG8_SB(1, 1), cB + hstep + kstep, voffB);
        PG8_BAR;
    } else if constexpr (SP2) {
        PG8_STAGE(PG8_SB(0, 0), cB, voffB); PG8_STAGE(PG8_SB(0, 1), cB + hstep, voffB); PG8_STAGE(PG8_SA(0, 0), cA, voffA); PG8_STAGE(PG8_SA(0, 1), cA + hstepA, voffA);
        if (wr == 1) PG8_BAR;
        PG8_WAIT_V(2); PG8_BAR;
        PG8_STAGE(PG8_SB(1, 0), cB + kstep, voffB); PG8_STAGE(PG8_SA(1, 0), cA + kstep, voffA); PG8_STAGE(PG8_SB(1, 1), cB + hstep + kstep, voffB);
        PG8_WAIT_V(6); PG8_BAR;
    } else {
        PG8_STAGE(PG8_SB(0, 0), cB, voffB); PG8_STAGE(PG8_SA(0, 0), cA, voffA); PG8_STAGE(PG8_SB(0, 1), cB + hstep, voffB); PG8_STAGE(PG8_SA(0, 1), cA + hstepA, voffA);
        if (wr == 1) PG8_BAR;
        PG8_WAIT_V(4); PG8_BAR;
        PG8_STAGE(PG8_SB(1, 0), cB + kstep, voffB); PG8_STAGE(PG8_SA(1, 0), cA + kstep, voffA); PG8_STAGE(PG8_SB(1, 1), cB + hstep + kstep, voffB);
        PG8_WAIT_V(6); PG8_BAR;
    }
    for (;;) {
        const bool has_next = S.next(ui + 1, nxt);
        const char* nA = has_next ? (const char*)g.A + (size_t)nxt.pm * tstep : cA; const char* nB = has_next ? (const char*)g.Bt + (size_t)nxt.pn * tstep : cB;
        for (int t = 0; t < nt; t += 2) {
            const bool last = (t == nt - 2);
            const char* a1 = cA + (size_t)(t + 1) * kstep;
            const char* a2 = last ? nA : cA + (size_t)(t + 2) * kstep; const char* b2 = last ? nB : cB + (size_t)(t + 2) * kstep;
            const char* a3 = a2 + kstep; const char* b3 = b2 + kstep;
            if (last && has_next) S.a_ready(nxt);
            if constexpr (SP2 && BAL) {
            constexpr int NS = Epi::NS_MIN; const bool first = REL && (t == 0);
            PG8_LDB(B0, 0, 0); PG8_LDB(B1, 0, 1); PG8_SCHED; PG8_LDA(At, 0, 0); if (!REL || !first) { PG8_STAGE(PG8_SA(1, 0), a1, voffA); PG8_STAGE(PG8_SA(1, 1), a1 + hstepA, voffA); }
            if (REL && first) PG8_WAIT_VN(8 + NS); else PG8_WAIT_V(8);
            PG8_WAIT_L(0); PG8_BAR; PG8_MMA(0, 0, At, B0); PG8_MMA(0, 1, At, B1); PG8_BAR; PG8_SCHED;
            PG8_LDA(At, 0, 1); PG8_STAGE(PG8_SB(0, 0), b2, voffB); PG8_STAGE(PG8_SB(0, 1), b2 + hstep, voffB);
            if (REL && first) PG8_WAIT_VN(6 + NS); else PG8_WAIT_V(6);
            PG8_WAIT_L(0); PG8_BAR; PG8_MMA(1, 0, At, B0); PG8_MMA(1, 1, At, B1); PG8_BAR; PG8_SCHED;
            PG8_LDB(B0, 1, 0); PG8_LDB(B1, 1, 1); PG8_SCHED; PG8_LDA(At, 1, 0); PG8_STAGE(PG8_SA(0, 0), a2, voffA); PG8_STAGE(PG8_SA(0, 1), a2 + hstepA, voffA);
            if (REL && first) PG8_WAIT_VN(8 + NS); else PG8_WAIT_V(8);
            PG8_WAIT_L(0); PG8_BAR; PG8_MMA(0, 0, At, B0); PG8_MMA(0, 1, At, B1); PG8_BAR; PG8_SCHED;
            PG8_LDA(At, 1, 1); PG8_STAGE(PG8_SB(1, 0), b3, voffB); PG8_STAGE(PG8_SB(1, 1), b3 + hstep, voffB);
            PG8_WAIT_V(6); PG8_WAIT_L(0); PG8_BAR; PG8_MMA(1, 0, At, B0); PG8_MMA(1, 1, At, B1); PG8_BAR; PG8_SCHED;
            } else if constexpr (SP2) {
            PG8_LDB(B0, 0, 0); PG8_LDB(B1, 0, 1); PG8_SCHED; PG8_LDA(At, 0, 0); PG8_STAGE(PG8_SA(1, 1), a1 + hstepA, voffA);
            PG8_WAIT_V(8); PG8_WAIT_L(0); PG8_BAR; PG8_MMA(0, 0, At, B0); PG8_MMA(0, 1, At, B1); PG8_BAR; PG8_SCHED;
            PG8_LDA(At, 0, 1); PG8_STAGE(PG8_SB(0, 0), b2, voffB); PG8_STAGE(PG8_SB(0, 1), b2 + hstep, voffB); PG8_STAGE(PG8_SA(0, 0), a2, voffA);
            PG8_WAIT_V(8); PG8_WAIT_L(0); PG8_BAR; PG8_MMA(1, 0, At, B0); PG8_MMA(1, 1, At, B1); PG8_BAR; PG8_SCHED;
            PG8_LDB(B0, 1, 0); PG8_LDB(B1, 1, 1); PG8_SCHED; PG8_LDA(At, 1, 0); PG8_STAGE(PG8_SA(0, 1), a2 + hstepA, voffA);
            PG8_WAIT_V(8); PG8_WAIT_L(0); PG8_BAR; PG8_MMA(0, 0, At, B0); PG8_MMA(0, 1, At, B1); PG8_BAR; PG8_SCHED;
            PG8_LDA(At, 1, 1); PG8_STAGE(PG8_SB(1, 0), b3, voffB); PG8_STAGE(PG8_SB(1, 1), b3 + hstep, voffB); PG8_STAGE(PG8_SA(1, 0), a3, voffA);
            PG8_WAIT_V(8); PG8_WAIT_L(0); PG8_BAR; PG8_MMA(1, 0, At, B0); PG8_MMA(1, 1, At, B1); PG8_BAR; PG8_SCHED;
            } else {
            PG8_LDB(B0, 0, 0); PG8_SCHED; PG8_LDA(At, 0, 0); PG8_STAGE(PG8_SA(1, 1), a1 + hstepA, voffA);
            PG8_WAIT_L(8); PG8_BAR; PG8_WAIT_L(0); PG8_MMA(0, 0, At, B0); PG8_BAR; PG8_SCHED;
            PG8_LDB(B1, 0, 1); PG8_STAGE(PG8_SB(0, 0), b2, voffB);
            PG8_BAR; PG8_WAIT_L(0); PG8_MMA(0, 1, At, B1); PG8_BAR;
            PG8_LDA(At, 0, 1); PG8_STAGE(PG8_SA(0, 0), a2, voffA);
            PG8_BAR; PG8_WAIT_L(0); PG8_MMA(1, 0, At, B0); PG8_BAR; PG8_SCHED;
            PG8_STAGE(PG8_SB(0, 1), b2 + hstep, voffB);
            PG8_WAIT_V(6); PG8_BAR; PG8_MMA(1, 1, At, B1); PG8_BAR;
            PG8_LDB(B0, 1, 0); PG8_SCHED; PG8_LDA(At, 1, 0); PG8_STAGE(PG8_SA(0, 1), a2 + hstepA, voffA);
            PG8_WAIT_L(8); PG8_BAR; PG8_WAIT_L(0); PG8_MMA(0, 0, At, B0); PG8_BAR; PG8_SCHED;
            PG8_LDB(B1, 1, 1); PG8_STAGE(PG8_SB(1, 0), b3, voffB);
            PG8_BAR; PG8_WAIT_L(0); PG8_MMA(0, 1, At, B1); PG8_BAR;
            PG8_LDA(At, 1, 1); PG8_STAGE(PG8_SA(1, 0), a3, voffA);
            PG8_BAR; PG8_WAIT_L(0); PG8_MMA(1, 0, At, B0); PG8_BAR; PG8_SCHED;
            PG8_STAGE(PG8_SB(1, 1), b3 + hstep, voffB);
            PG8_WAIT_V(6); PG8_BAR; PG8_MMA(1, 1, At, B1); PG8_BAR;
            }
        }
        if constexpr (SP2 && BAL && REL) { if (has_next) { PG8_STAGE(PG8_SA(1, 0), nA + kstep, voffA); PG8_STAGE(PG8_SA(1, 1), nA + kstep + hstepA, voffA); } }
        if constexpr (ALIGN_EPI) { if (wr == 0) PG8_BAR; }
        if constexpr (!Epi::AFTER_DRAIN) { E(acc, cur, wr, wc, fr, fq); S.done(cur); }
        if (!has_next) break;
#pragma unroll
        for (int a = 0; a < 2; ++a)
#pragma unroll
            for (int b = 0; b < 2; ++b)
#pragma unroll
                for (int m = 0; m < 4; ++m)
#pragma unroll
                    for (int n = 0; n < 2; ++n) acc[a][b][m][n] = (acc_t){0, 0, 0, 0};
        cur = nxt; cA = nA; cB = nB; ++ui;
        if constexpr (ALIGN_EPI) { if (wr == 1) PG8_BAR; }
    }
    PG8_WAIT_V(0);
    if constexpr (!ALIGN_EPI) { if (wr == 0) PG8_BAR; }
    PG8_BAR;
#undef PG8_SA
#undef PG8_SB
#undef PG8_STAGE
#undef pvoffA
#undef pvoffB
#undef PG8_LDA
#undef PG8_LDB
#undef PG8_MMA
#undef PG8_WAIT_V
#undef PG8_WAIT_VN
#undef PG8_WAIT_L
#undef PG8_BAR
#undef PG8_SCHED
}
}
#define PG8_SP2 true
#define PG8_ALIGN true
#define PG8_BAL true

namespace att {
constexpr int D = 128, NW = 8, QBLK = 32, KVBLK = 64;
constexpr float SCALE = 0.088388347648318440f;
constexpr float THR = 5.f;
constexpr int LDQ = DM, LDK = KVD;
constexpr size_t SHM_V = KVBLK * D * 2, SHM_K = KVBLK * D * 2, SHM_K8 = KVBLK * D;
#define KSWZ(row, colB) ((row) * 256 + ((colB) ^ (((row) & 7) << 4)))
#define SBAR() __builtin_amdgcn_sched_barrier(0)
__device__ __forceinline__ int crow(int r, int hi) { return (r & 3) + 8 * (r >> 2) + 4 * hi; }
__device__ __forceinline__ unsigned cvtpk(float lo, float hi) { unsigned r; asm volatile("v_cvt_pk_bf16_f32 %0, %1, %2" : "=v"(r) : "v"(lo), "v"(hi)); return r; }
__device__ __forceinline__ void partialSM(f32x16& p0, f32x16& p1, float& m_reg, float& mn, float& alpha) {
  constexpr float C = SCALE * 1.4426950408889634f, THRQ = THR / SCALE;
  float pmax = p0[0];
#pragma unroll
  for (int r = 1; r < 16; ++r) pmax = fmaxf(pmax, p0[r]);
#pragma unroll
  for (int r = 0; r < 16; ++r) pmax = fmaxf(pmax, p1[r]);
  { auto rr = __builtin_amdgcn_permlane32_swap(__float_as_uint(pmax), __float_as_uint(pmax), false, false);
    pmax = fmaxf(__uint_as_float(rr[0]), __uint_as_float(rr[1])); }
  if (__builtin_expect(__all(pmax - m_reg <= THRQ), 1)) { mn = m_reg; alpha = 1.f; }
  else { mn = fmaxf(m_reg, pmax); alpha = __builtin_amdgcn_exp2f((m_reg - mn) * C); m_reg = mn; }
  float mnC = -mn * C;
#pragma unroll
  for (int r = 0; r < 16; ++r) p0[r] = fmaf(p0[r], C, mnC);
#pragma unroll
  for (int r = 0; r < 16; ++r) p1[r] = fmaf(p1[r], C, mnC);
#pragma unroll
  for (int r = 0; r < 16; ++r) p0[r] = __builtin_amdgcn_exp2f(p0[r]);
}
typedef int i32x8 __attribute__((ext_vector_type(8)));
__device__ __forceinline__ int cvt4_fp8(float a, float b, float c, float d) { int w = __builtin_amdgcn_cvt_pk_fp8_f32(a, b, 0, false); return __builtin_amdgcn_cvt_pk_fp8_f32(c, d, w, true); }
__device__ __forceinline__ void finishSM(f32x16& p0, f32x16& p1, i32x8& pf) {
#pragma unroll
  for (int r = 0; r < 16; ++r) p1[r] = __builtin_amdgcn_exp2f(p1[r]);
#pragma unroll
  for (int i = 0; i < 4; ++i) { pf[i] = cvt4_fp8(p0[4 * i], p0[4 * i + 1], p0[4 * i + 2], p0[4 * i + 3]); pf[4 + i] = cvt4_fp8(p1[4 * i], p1[4 * i + 1], p1[4 * i + 2], p1[4 * i + 3]); }
}
#define KSWZ8(row, colB) ((row) * 128 + ((colB) ^ ((((row) >> 1) & 7) << 4)))
__device__ __forceinline__ void qkt(f32x16& p0, f32x16& p1, const char* Ks, const i32x8* qr, int r32, int hi) {
  p0 = f32x16{}; p1 = f32x16{};
#pragma unroll
  for (int d0 = 0; d0 < 2; ++d0) { const int cb = d0 * 64 + hi * 32;
    const i32x4 a0 = *reinterpret_cast<const i32x4*>(Ks + KSWZ8(r32, cb)), a1 = *reinterpret_cast<const i32x4*>(Ks + KSWZ8(r32, cb + 16));
    const i32x4 b0 = *reinterpret_cast<const i32x4*>(Ks + KSWZ8(32 + r32, cb)), b1 = *reinterpret_cast<const i32x4*>(Ks + KSWZ8(32 + r32, cb + 16));
    const i32x8 k0 = {a0[0], a0[1], a0[2], a0[3], a1[0], a1[1], a1[2], a1[3]}, k1 = {b0[0], b0[1], b0[2], b0[3], b1[0], b1[1], b1[2], b1[3]};
    p0 = __builtin_amdgcn_mfma_scale_f32_32x32x64_f8f6f4(k0, qr[d0], p0, 0, 0, 0, 0x7f7f7f7f, 0, 0x7f7f7f7f);
    p1 = __builtin_amdgcn_mfma_scale_f32_32x32x64_f8f6f4(k1, qr[d0], p1, 0, 0, 0, 0x7f7f7f7f, 0, 0x7f7f7f7f); }
}
__device__ __forceinline__ void pv_fp8(f32x16* o, f32x16& ol, const char* Vt, int voA, int voB, const i32x8 pf) {
  const i32x8 ones = {0x38383838, 0x38383838, 0x38383838, 0x38383838, 0x38383838, 0x38383838, 0x38383838, 0x38383838};
  ol = __builtin_amdgcn_mfma_scale_f32_32x32x64_f8f6f4(pf, ones, ol, 0, 0, 0, 0x7f7f7f7f, 0, 0x7f7f7f7f);
#pragma unroll
  for (int d0 = 0; d0 < 4; ++d0) {
    const i32x4 a = *reinterpret_cast<const i32x4*>(Vt + d0 * 2048 + voA), b = *reinterpret_cast<const i32x4*>(Vt + d0 * 2048 + voB);
    const i32x8 vf = {a[0], a[1], a[2], a[3], b[0], b[1], b[2], b[3]};
    o[d0] = __builtin_amdgcn_mfma_scale_f32_32x32x64_f8f6f4(pf, vf, o[d0], 0, 0, 0, 0x7f7f7f7f, 0, 0x7f7f7f7f);
  }
}
__device__ __forceinline__ float bflo(unsigned w) { return __uint_as_float(w << 16); }
__device__ __forceinline__ float bfhi(unsigned w) { return __uint_as_float(w & 0xffff0000u); }
struct Merge { const bf16* SGA; const bf16* GBS; const bf16* P; const float* cw; const float* cb; };
__device__ __forceinline__ void attn_unit(const signed char* __restrict__ Qb, bf16* __restrict__ Ob, const signed char* __restrict__ Kh, const unsigned char* __restrict__ Vh, int seq, int t0, size_t grow0, int h,
                                          const Merge& mg, char* lds, char* scr, int tid) {
  const int wid = tid >> 6, lane = tid & 63, r32 = lane & 31, hi = lane >> 5;
  char* V_lds = lds; char* K_lds = lds + 2 * SHM_K8;
  float* al_l = (float*)scr + wid * 64 + 32;
  float m_reg = -1e30f; f32x16 o[4] = {}, ol = {}; i32x8 qr[2];
  const signed char* Qw = Qb + (long)(wid * QBLK + r32) * LDQ + hi * 32;
#pragma unroll
  for (int d0 = 0; d0 < 2; ++d0) { const i32x4 a = *reinterpret_cast<const i32x4*>(Qw + d0 * 64), b = *reinterpret_cast<const i32x4*>(Qw + d0 * 64 + 16); qr[d0] = (i32x8){a[0], a[1], a[2], a[3], b[0], b[1], b[2], b[3]}; }
  const int vd = tid >> 2, vst = vd * 64 + (((tid & 3) ^ ((vd >> 2) & 3)) << 4);
  const int vsw = (r32 >> 2) & 3, voA = r32 * 64 + (((2 * hi) ^ vsw) << 4), voB = r32 * 64 + (((2 * hi + 1) ^ vsw) << 4);
  struct { i32x4 vs, ks; } sr_[2];
  const int kr = tid >> 3, kc = (tid & 7) * 16; const unsigned ko8 = (unsigned)(kr * LDK + kc);
  const unsigned vo8 = (unsigned)tid * 16u;
#define SLOAD(i, k0) do { const unsigned char* vt_ = Vh + (size_t)(k0) * 128; const signed char* kt_ = Kh + (size_t)(k0) * LDK; \
    sr_[i].vs = *reinterpret_cast<const i32x4*>(vt_ + vo8); sr_[i].ks = *reinterpret_cast<const i32x4*>(kt_ + ko8); } while (0)
#define SWRITE(b, i) do { *(i32x4*)(V_lds + (b) * SHM_K8 + vst) = sr_[i].vs; *(i32x4*)(K_lds + (b) * SHM_K8 + KSWZ8(kr, kc)) = sr_[i].ks; } while (0)
#define SWAIT() asm volatile("s_waitcnt vmcnt(2)" ::: "memory")
#define RESC(a) do { if (__any((a) < 1.f)) { if (hi == 0) al_l[r32] = (a); asm volatile("s_waitcnt lgkmcnt(0)" ::: "memory"); \
    _Pragma("unroll") for (int r = 0; r < 16; ++r) { const float a_ = al_l[crow(r, hi)]; ol[r] *= a_; _Pragma("unroll") for (int d = 0; d < 4; ++d) o[d][r] *= a_; } } } while (0)
  f32x16 pA0, pA1, pB0, pB1; float mnA, mnB, alA, alB; i32x8 pf; const int NT = seq / KVBLK;
  constexpr int SE = 0, SO = 1;
  SLOAD(SE, 0); asm volatile("s_waitcnt vmcnt(0)" ::: "memory"); SWRITE(0, SE); __syncthreads();
  qkt(pA0, pA1, K_lds, qr, r32, hi); partialSM(pA0, pA1, m_reg, mnA, alA);
  SLOAD(SO, KVBLK); if (2 < NT) SLOAD(SE, 2 * KVBLK);
  SWAIT(); SWRITE(1, SO); __syncthreads();
  for (int j = 1; j + 1 < NT; j += 2) {
    SBAR(); qkt(pB0, pB1, K_lds + SHM_K8, qr, r32, hi);
    finishSM(pA0, pA1, pf); SBAR();
    SLOAD(SO, (j + 2) * KVBLK); SBAR();
    pv_fp8(o, ol, V_lds, voA, voB, pf); partialSM(pB0, pB1, m_reg, mnB, alB);
    __syncthreads(); SWAIT(); SWRITE(0, SE);
    RESC(alB); __syncthreads();
    SBAR(); qkt(pA0, pA1, K_lds, qr, r32, hi);
    finishSM(pB0, pB1, pf); SBAR();
    if (j + 3 < NT) SLOAD(SE, (j + 3) * KVBLK); SBAR();
    pv_fp8(o, ol, V_lds + SHM_K8, voA, voB, pf); partialSM(pA0, pA1, m_reg, mnA, alA);
    __syncthreads(); SWAIT(); SWRITE(1, SO);
    RESC(alA); __syncthreads();
  }
  SBAR(); qkt(pB0, pB1, K_lds + SHM_K8, qr, r32, hi);
  finishSM(pA0, pA1, pf); SBAR();
  pv_fp8(o, ol, V_lds, voA, voB, pf); partialSM(pB0, pB1, m_reg, mnB, alB);
  __syncthreads(); RESC(alB);
  finishSM(pB0, pB1, pf); SBAR();
  pv_fp8(o, ol, V_lds + SHM_K8, voA, voB, pf);
  float rli[16];
#pragma unroll
  for (int r = 0; r < 16; ++r) rli[r] = __builtin_amdgcn_rcpf(ol[r]);
  asm volatile("s_waitcnt vmcnt(0) lgkmcnt(0)" ::: "memory");
  __syncthreads();
  float* OS = (float*)(lds + wid * 16384);
#pragma unroll
  for (int r = 0; r < 16; ++r) { const int orow = crow(r, hi);
#pragma unroll
    for (int d0 = 0; d0 < 4; ++d0) OS[orow * 128 + d0 * 32 + r32] = o[d0][r] * rli[r]; }
  asm volatile("s_waitcnt lgkmcnt(0)" ::: "memory");
  int tid2 = tid; asm volatile("" : "+v"(tid2));
  const int lane2 = tid2 & 63, cg = lane2 & 15, rl = lane2 >> 4, col = h * 128 + cg * 8, widu = __builtin_amdgcn_readfirstlane(tid2 >> 6);
  float w0[8], w1[8], w2[8], cbv[8];
#pragma unroll
  for (int e = 0; e < 8; ++e) { w0[e] = mg.cw[col + e]; w1[e] = mg.cw[DM + col + e]; w2[e] = mg.cw[2 * DM + col + e]; cbv[e] = mg.cb[col + e]; }
  const size_t wbase = (grow0 + (size_t)(widu * 32)) * DM + (size_t)(h * 128);
  const unsigned loff = (unsigned)(rl * DM + cg * 8);
  const float* OSr = OS + rl * 128 + cg * 8;
  struct MgLd { u32x4 sg, gb, pc, pm, pp; };
#define MG_LOAD(PS, D) do { const int ps_ = (PS); const int t_ = t0 + widu * 32 + ps_ * 4 + rl; const size_t ub_ = wbase + (size_t)(ps_ * 4) * DM; \
    const bf16* pcp_ = mg.P + ub_; (D).sg = *(const u32x4*)(mg.SGA + ub_ + loff); (D).gb = *(const u32x4*)(mg.GBS + ub_ + loff); (D).pc = *(const u32x4*)(pcp_ + loff); \
    (D).pm = (u32x4){0u, 0u, 0u, 0u}; (D).pp = (u32x4){0u, 0u, 0u, 0u}; if (t_ > 0) (D).pm = *(const u32x4*)(pcp_ - DM + loff); if (t_ < seq - 1) (D).pp = *(const u32x4*)(pcp_ + DM + loff); } while (0)
#define MG_COMP(PS, D) do { const int ps_ = (PS); const f32x4 a0 = *(const f32x4*)(OSr + ps_ * 512), a1 = *(const f32x4*)(OSr + ps_ * 512 + 4); \
    const float av[8] = {a0[0], a0[1], a0[2], a0[3], a1[0], a1[1], a1[2], a1[3]}; float ov[8]; \
    _Pragma("unroll") for (int e = 0; e < 8; ++e) { const unsigned wsg = (D).sg[e >> 1], wgb = (D).gb[e >> 1], wpc = (D).pc[e >> 1], wpm = (D).pm[e >> 1], wpp = (D).pp[e >> 1]; \
      const float fsg = (e & 1) ? bfhi(wsg) : bflo(wsg), fgb = (e & 1) ? bfhi(wgb) : bflo(wgb), fpc = (e & 1) ? bfhi(wpc) : bflo(wpc), fpm = (e & 1) ? bfhi(wpm) : bflo(wpm), fpp = (e & 1) ? bfhi(wpp) : bflo(wpp); \
      const float cv = fmaf(w0[e], fpm, fmaf(w1[e], fpc, fmaf(w2[e], fpp, cbv[e]))); ov[e] = fmaf(fsg, av[e], fgb * cv); } \
    u32x4 w_; w_.x = cvtpk(ov[0], ov[1]); w_.y = cvtpk(ov[2], ov[3]); w_.z = cvtpk(ov[4], ov[5]); w_.w = cvtpk(ov[6], ov[7]); \
    *(u32x4*)(Ob + (size_t)(widu * 32 + ps_ * 4) * LDQ + loff) = w_; } while (0)
  MgLd LA, LB;
  MG_LOAD(0, LA);
#pragma unroll 1
  for (int ps = 0; ps < 8; ps += 2) { MG_LOAD(ps + 1, LB); MG_COMP(ps, LA); if (ps + 2 < 8) MG_LOAD(ps + 2, LA); MG_COMP(ps + 1, LB); }
#undef MG_LOAD
#undef MG_COMP
  asm volatile("s_waitcnt lgkmcnt(0)" ::: "memory");
  __syncthreads();
#undef SLOAD
#undef SWRITE
#undef SWAIT
#undef RESC
}
}

typedef GAS unsigned gu32;
#define RLX_AGENT __ATOMIC_RELAXED, __HIP_MEMORY_SCOPE_AGENT
#define LDS_WAIT() asm volatile("s_waitcnt lgkmcnt(0)" ::: "memory")
#define VM_WAIT() asm volatile("s_waitcnt vmcnt(0)" ::: "memory")
__device__ __forceinline__ unsigned f2bf(float f) { unsigned u = __builtin_bit_cast(unsigned, f); return (u + 0x7fffu + ((u >> 16) & 1u)) >> 16; }
__device__ __forceinline__ unsigned pk2(float lo, float hi) { unsigned r; asm volatile("v_cvt_pk_bf16_f32 %0, %1, %2" : "=v"(r) : "v"(lo), "v"(hi)); return r; }
__device__ __forceinline__ float bflo(unsigned w) { return __uint_as_float(w << 16); }
__device__ __forceinline__ float bfhi(unsigned w) { return __uint_as_float(w & 0xffff0000u); }

#define XB_TMO      128
#define XB_XCNT(j)  (256  + 64 * (j))
#define XB_XSUB(j)  (1280 + 64 * (j))
#define XB_XGEN(j)  (2304 + 64 * (j))
#define XB_TOP      3328
#define XB_TOPGEN   3392
#define XCD_BAR_WORDS 3456
#define XB_SPIN_CAP (1u << 18)
__device__ __forceinline__ unsigned xb_ld(unsigned* p)              { return __hip_atomic_load(p, __ATOMIC_RELAXED, __HIP_MEMORY_SCOPE_AGENT); }
__device__ __forceinline__ unsigned xb_add(unsigned* p, unsigned v) { return __hip_atomic_fetch_add(p, v, __ATOMIC_RELAXED, __HIP_MEMORY_SCOPE_AGENT); }
__device__ __forceinline__ unsigned xb_xcc_id() { return (unsigned)__builtin_amdgcn_s_getreg((3 << 11) | 20) & 0xFu; }
#define XB_SPIN(cond, bar) do { unsigned _sp = 0; while (cond) { __builtin_amdgcn_s_sleep(1); \
    if ((++_sp & 255u) == 0u) { if (xb_ld(&(bar)[XB_TMO])) break; if (_sp > XB_SPIN_CAP) { atomicAdd(&(bar)[XB_TMO], 1u); break; } } } } while (0)
struct XcdBarrier { unsigned* bar; unsigned x; volatile LAS unsigned* st; };
__device__ __forceinline__ XcdBarrier xcd_barrier_post(unsigned* bar, volatile LAS unsigned* st) {
    XcdBarrier b; b.bar = bar; b.x = xb_xcc_id(); b.st = st;
    if (threadIdx.x == 0) (void)xb_add(&bar[XB_XCNT(b.x)], 1u);
    return b;
}
__device__ __forceinline__ void xcd_barrier_complete(unsigned* bar, unsigned x, unsigned& nloc, unsigned& nx) {
    const unsigned G = gridDim.x * gridDim.y * gridDim.z;
    unsigned sum, cnt, mine, sp = 0u;
    for (;;) {
        sum = 0u; cnt = 0u; mine = 0u;
#pragma unroll
        for (unsigned j = 0; j < 16; ++j) { const unsigned c = xb_ld(&bar[XB_XCNT(j)]); sum += c; cnt += (c > 0u) ? 1u : 0u; mine = (j == x) ? c : mine; }
        if (sum == G) break;
        __builtin_amdgcn_s_sleep(1);
        if ((++sp & 255u) == 0u) { if (xb_ld(&bar[XB_TMO])) break; if (sp > XB_SPIN_CAP) { atomicAdd(&bar[XB_TMO], 1u); break; } }
    }
    nloc = mine > 0u ? mine : 1u; nx = cnt > 0u ? cnt : 1u;
}
__device__ __forceinline__ void xcd_barrier(const XcdBarrier& b) {
    asm volatile("s_waitcnt vmcnt(0)" ::: "memory");
    __syncthreads();
    if (threadIdx.x == 0) {
        unsigned* bar = b.bar;
        __builtin_amdgcn_s_waitcnt(0);
        unsigned nloc = b.st[0], nx = b.st[1];
        if (nloc == 0u) { xcd_barrier_complete(bar, b.x, nloc, nx); b.st[0] = nloc; b.st[1] = nx; }
        const unsigned old = xb_add(&bar[XB_XSUB(b.x)], 1u);
        const unsigned gen = old / nloc;
        if (old + 1u == (gen + 1u) * nloc) {
            __builtin_amdgcn_fence(__ATOMIC_RELEASE, "agent");
            asm volatile("s_waitcnt vmcnt(0)" ::: "memory");
            const unsigned og = xb_add(&bar[XB_TOP], 1u);
            const unsigned tg = og / nx;
            if (og + 1u == (tg + 1u) * nx) xb_add(&bar[XB_TOPGEN], 1u);
            else XB_SPIN(xb_ld(&bar[XB_TOPGEN]) == tg, bar);
            __builtin_amdgcn_fence(__ATOMIC_ACQUIRE, "agent");
            xb_add(&bar[XB_XGEN(b.x)], 1u);
            asm volatile("s_waitcnt vmcnt(0)" ::: "memory");
        } else {
            XB_SPIN(xb_ld(&bar[XB_XGEN(b.x)]) == gen, bar);
            __builtin_amdgcn_fence(__ATOMIC_ACQUIRE, "agent");
            asm volatile("s_waitcnt vmcnt(0)" ::: "memory");
        }
    }
    __syncthreads();
}

struct Args {
    const float *xp, *xs, *cp, *cs, *w_ada, *b_ada, *g_mix_pre, *w_in, *g_q, *g_k, *conv_w, *conv_b, *w_o, *g_mix_post, *g_ffn_pre, *w_up, *ffn_conv_w, *ffn_conv_b, *w_down, *g_ffn_post;
    float* out; unsigned char* ws; int ph_lo, ph_hi;
};
struct Frame { LAS unsigned char* lds; int tid, lane, wave, vcu, G; };
typedef const Args __attribute__((address_space(4)))* ArgsP;
__device__ __forceinline__ ArgsP kargs() { ArgsP p = (ArgsP)__builtin_amdgcn_kernarg_segment_ptr(); asm volatile("" : "+s"(p)); return p; }
__device__ __forceinline__ Frame make_frame(LAS unsigned char* lds) { Frame F; F.lds = lds; int t = threadIdx.x; asm volatile("" : "+v"(t)); F.tid = t; F.lane = t & 63; F.wave = __builtin_amdgcn_readfirstlane(t >> 6);
    F.G = gridDim.x; { const int bx = blockIdx.x; F.vcu = (F.G % 8 == 0) ? (bx % 8) * (F.G / 8) + bx / 8 : bx; } return F; }

__device__ __forceinline__ float wave_sum(float v) {
#pragma unroll
    for (int o = 1; o < 64; o <<= 1) v += __shfl_xor(v, o);
    return v;
}
__device__ __forceinline__ int seq_of(int m) { return m < MP ? (m >> 11) : 8; }
__device__ __forceinline__ int pos_of(int m) { return m < MP ? (m & (SEQP - 1)) : (m - MP); }
__device__ __forceinline__ const float* xrow(const float* xp, const float* xs, int m) { return m < MP ? xp + (size_t)m * DM : xs + (size_t)(m - MP) * DM; }

__device__ __forceinline__ int inA_logical(int np) {
    const int pn = np >> 8, c = np & 255;
    return (c < 128 ? 10240 : 14336) + 128 * pn + (c & 127);
}
__device__ __forceinline__ int inB_logical(int np) {
    if (np < 6144) return np;
    if (np < 10240) return np + 12288;
    const int pn = (np - 10240) >> 8, c = np & 255;
    return (c < 128 ? 6144 : 22528) + 128 * pn + (c & 127);
}
__device__ __forceinline__ int up_logical(int np) { const int pn = np >> 8, c = np & 255; return (c < 128 ? 0 : DFF) + 128 * pn + (c & 127); }

__device__ __forceinline__ int qk_perm6(int d) { return (d & 3) | (((d >> 5) & 1) << 2) | (((d >> 2) & 3) << 3) | (((d >> 4) & 1) << 5); }
template <bool QKP> __device__ __forceinline__ void transpose_item(const float* W, int K, int N, bf16* WT, int k0, int nlog0, int nphys0, LAS float* scr, int lane) {
    const float* src = W + (size_t)k0 * N + nlog0 + lane;
#pragma unroll 16
    for (int i = 0; i < 64; ++i) scr[i * 65 + lane] = src[(size_t)i * N];
    LDS_WAIT(); asm volatile("" ::: "memory");
    const int c = lane & 7, n8 = lane >> 3;
#pragma unroll
    for (int j = 0; j < 8; ++j) { const int n = n8 + 8 * j; const LAS float* s = scr + (8 * c) * 65 + n;
        u32x4 o; o.x = pk2(s[0], s[65]); o.y = pk2(s[2 * 65], s[3 * 65]); o.z = pk2(s[4 * 65], s[5 * 65]); o.w = pk2(s[6 * 65], s[7 * 65]);
        *(GAS u32x4*)(WT + (size_t)(nphys0 + (QKP ? qk_perm6(n) : n)) * K + k0 + 8 * c) = o; }
    LDS_WAIT(); asm volatile("" ::: "memory");
}

__device__ __forceinline__ void amax_item(bool QKP, const float* W, int N, int k0, int nlog0, int nphys0, unsigned* camax, int lane) {
    const float* src = W + (size_t)k0 * N + nlog0 + lane; float m = 0.f;
#pragma unroll 8
    for (int i = 0; i < 64; ++i) m = fmaxf(m, fabsf(src[(size_t)i * N]));
    (void)__hip_atomic_fetch_max(camax + nphys0 + (QKP ? qk_perm6(lane) : lane), __float_as_uint(m), __ATOMIC_RELAXED, __HIP_MEMORY_SCOPE_AGENT);
}
template <bool SAT> __device__ __forceinline__ unsigned pack_q8s(float a, float b, float c, float d, float s) {
    const float M = 12582912.0f; float ya, yb, yc, yd;
    if (SAT) { ya = __builtin_amdgcn_fmed3f(a * s, -127.f, 127.f) + M; yb = __builtin_amdgcn_fmed3f(b * s, -127.f, 127.f) + M; yc = __builtin_amdgcn_fmed3f(c * s, -127.f, 127.f) + M; yd = __builtin_amdgcn_fmed3f(d * s, -127.f, 127.f) + M; }
    else { ya = fmaf(a, s, M); yb = fmaf(b, s, M); yc = fmaf(c, s, M); yd = fmaf(d, s, M); }
    return __builtin_amdgcn_perm(__float_as_uint(yb), __float_as_uint(ya), 0x0c0c0400u) | __builtin_amdgcn_perm(__float_as_uint(yd), __float_as_uint(yc), 0x04000c0cu);
}
__device__ __forceinline__ unsigned pack_q8(float a, float b, float c, float d) { return pack_q8s<true>(a, b, c, d, 1.0f); }
__device__ __forceinline__ void transpose_item_i8(bool QKP, const float* W, int K, int N, signed char* W8, int k0, int nlog0, int nphys0, const unsigned* camax, float* swp, LAS float* scr, int lane) {
    const float* src = W + (size_t)k0 * N + nlog0 + lane;
#pragma unroll 16
    for (int i = 0; i < 64; ++i) scr[i * 65 + lane] = src[(size_t)i * N];
    LDS_WAIT(); asm volatile("" ::: "memory");
    const int c = lane & 3, n16 = lane >> 2;
#pragma unroll
    for (int j = 0; j < 4; ++j) { const int n = n16 + 16 * j, np = nphys0 + (QKP ? qk_perm6(n) : n); const LAS float* sp = scr + (16 * c) * 65 + n;
        const float amax = __uint_as_float(camax[np]), inv = amax > 0.f ? 127.0f / amax : 0.f;
        u32x4 o; o.x = pack_q8(sp[0] * inv, sp[65] * inv, sp[2 * 65] * inv, sp[3 * 65] * inv); o.y = pack_q8(sp[4 * 65] * inv, sp[5 * 65] * inv, sp[6 * 65] * inv, sp[7 * 65] * inv);
        o.z = pack_q8(sp[8 * 65] * inv, sp[9 * 65] * inv, sp[10 * 65] * inv, sp[11 * 65] * inv); o.w = pack_q8(sp[12 * 65] * inv, sp[13 * 65] * inv, sp[14 * 65] * inv, sp[15 * 65] * inv);
        *(GAS u32x4*)(W8 + (size_t)np * K + k0 + 16 * c) = o;
        if (k0 == 0 && c == 0) swp[np] = amax * (1.0f / 127.0f); }
    LDS_WAIT(); asm volatile("" ::: "memory");
}

__device__ __forceinline__ void fwht64(float (&v)[64]) {
#pragma unroll
    for (int st = 1; st < 64; st <<= 1)
#pragma unroll
        for (int i = 0; i < 64; ++i) if (!(i & st)) { const float a = v[i], b = v[i + st]; v[i] = a + b; v[i + st] = a - b; }
}
__device__ __forceinline__ f32x4 fwht64_row(f32x4 x, int lane) {
    { const float a = x[0] + x[1], b = x[0] - x[1], c = x[2] + x[3], d = x[2] - x[3]; x[0] = a + c; x[1] = b + d; x[2] = a - c; x[3] = b - d; }
#define FW_DPP(v, ctrl) __int_as_float(__builtin_amdgcn_update_dpp(0, __float_as_int(v), (ctrl), 0xf, 0xf, true))
#pragma unroll
    for (int e = 0; e < 4; ++e) { float own = x[e], pr;
        pr = FW_DPP(own, 0xB1); own = (lane & 1) ? pr - own : own + pr;
        pr = FW_DPP(own, 0x4E); own = (lane & 2) ? pr - own : own + pr;
        { const float up = FW_DPP(own, 0x104), dn = FW_DPP(own, 0x114); own = (lane & 4) ? dn - own : own + up; }
        { const float up = FW_DPP(own, 0x108), dn = FW_DPP(own, 0x118); own = (lane & 8) ? dn - own : own + up; }
        x[e] = own; }
#undef FW_DPP
    return x;
}
__device__ __forceinline__ void amax_item_h(bool QKP, const float* W, int N, int k0, int nlog0, int nphys0, unsigned* camax, int lane) {
    const float* src = W + (size_t)k0 * N + nlog0 + lane; float v[64];
#pragma unroll
    for (int i = 0; i < 64; ++i) v[i] = src[(size_t)i * N];
    fwht64(v); float m = 0.f;
#pragma unroll
    for (int i = 0; i < 64; ++i) m = fmaxf(m, fabsf(v[i]));
    (void)__hip_atomic_fetch_max(camax + nphys0 + (QKP ? qk_perm6(lane) : lane), __float_as_uint(m), __ATOMIC_RELAXED, __HIP_MEMORY_SCOPE_AGENT);
}
__device__ __forceinline__ void transpose_item_i8_h(bool QKP, const float* W, int K, int N, signed char* W8, int k0, int nlog0, int nphys0, const unsigned* camax, float* swp, int lane) {
    const float* src = W + (size_t)k0 * N + nlog0 + lane; float v[64];
#pragma unroll
    for (int i = 0; i < 64; ++i) v[i] = src[(size_t)i * N];
    fwht64(v);
    const int np = nphys0 + (QKP ? qk_perm6(lane) : lane); const float amax = AMX_SAFETY * __uint_as_float(camax[np]), inv = amax > 0.f ? 127.0f / amax : 0.f;
    GAS u32x4* dst = (GAS u32x4*)(W8 + (size_t)np * K + k0);
#pragma unroll
    for (int q = 0; q < 4; ++q) { u32x4 o; o.x = pack_q8s<true>(v[16 * q], v[16 * q + 1], v[16 * q + 2], v[16 * q + 3], inv); o.y = pack_q8s<true>(v[16 * q + 4], v[16 * q + 5], v[16 * q + 6], v[16 * q + 7], inv);
        o.z = pack_q8s<true>(v[16 * q + 8], v[16 * q + 9], v[16 * q + 10], v[16 * q + 11], inv); o.w = pack_q8s<true>(v[16 * q + 12], v[16 * q + 13], v[16 * q + 14], v[16 * q + 15], inv); dst[q] = o; }
    if (k0 == 0) swp[np] = amax * (1.0f / (127.0f * 64.0f));
}

__device__ __forceinline__ void sincos_d(double a, double& s, double& c) {
    const double TWO_PI_HI = 6.283185307179586, TWO_PI_LO = 2.4492935982947064e-16;
    const double k = __builtin_rint(a * 0.15915494309189535);
    double r = __builtin_fma(-k, TWO_PI_HI, a); r = __builtin_fma(-k, TWO_PI_LO, r);
    const double q = r * 0.25, z = q * q;
    double sp = -1.0 / 1307674368000.0; sp = sp * z + 1.0 / 6227020800.0; sp = sp * z - 1.0 / 39916800.0; sp = sp * z + 1.0 / 362880.0; sp = sp * z - 1.0 / 5040.0; sp = sp * z + 1.0 / 120.0; sp = sp * z - 1.0 / 6.0; sp = sp * z + 1.0;
    double cp = 1.0 / 20922789888000.0; cp = cp * z - 1.0 / 87178291200.0; cp = cp * z + 1.0 / 479001600.0; cp = cp * z - 1.0 / 3628800.0; cp = cp * z + 1.0 / 40320.0; cp = cp * z - 1.0 / 720.0; cp = cp * z + 1.0 / 24.0; cp = cp * z - 0.5; cp = cp * z + 1.0;
    double s1 = q * sp, c1 = cp;
    double s2 = 2.0 * s1 * c1, c2 = 1.0 - 2.0 * s1 * s1;
    s = 2.0 * s2 * c2; c = 1.0 - 2.0 * s2 * s2;
}

__device__ __forceinline__ void phase0(LAS unsigned char* lds_) {
    const ArgsP ap = kargs(); Frame F = make_frame(lds_);
    unsigned char* ws = ap->ws;
    { const int idx = blockIdx.x * 512 + F.tid;
      if (idx < 4096) { const int pos = idx >> 5, f = idx & 31; double inv = 1.0; for (int i = 0; i < f; ++i) inv *= 0.7498942093324558;
          double s, c; sincos_d((double)pos * inv, s, c); float* rope = (float*)(ws + WS_ROPE); rope[idx] = (float)c; rope[4096 + idx] = (float)s; } }
    float* mod = (float*)(ws + WS_MOD);
    {
        LAS float* sc = (LAS float*)(F.lds + F.wave * 6144);
        LAS float* RED = (LAS float*)(F.lds + 49152);
        const int sub = F.lane / 24, c4 = F.lane - 24 * sub; const bool actv = F.lane < 48; const int kw0 = F.wave * 512;
        for (int cb = blockIdx.x; cb < (6 * DM) / 96; cb += F.G) {
            const int n0 = cb * 96;
            f32x4 acc[9];
#pragma unroll
            for (int sq = 0; sq < 9; ++sq) acc[sq] = (f32x4){0.f, 0.f, 0.f, 0.f};
            for (int kc = 0; kc < 512; kc += 128) {
                for (int idx = F.lane; idx < 128 * 9; idx += 64) { const int k = idx / 9, sq = idx - 9 * k; const float c = sq < 8 ? ap->cp[sq * DM + kw0 + kc + k] : ap->cs[kw0 + kc + k]; sc[k * 12 + sq] = c / (1.0f + __expf(-c)); }
                LDS_WAIT(); asm volatile("" ::: "memory");
                if (actv) { const float* wp = ap->w_ada + (size_t)(kw0 + kc + sub) * (6 * DM) + n0 + 4 * c4;
#pragma unroll 8
                    for (int it = 0; it < 64; ++it) {
                        const f32x4 w = *(const f32x4*)(wp + (size_t)it * (2 * 6 * DM)); const LAS float* sr = sc + (2 * it + sub) * 12;
                        const f32x4 s0 = *(const LAS f32x4*)sr, s1 = *(const LAS f32x4*)(sr + 4), s2 = *(const LAS f32x4*)(sr + 8);
                        acc[0] += s0[0] * w; acc[1] += s0[1] * w; acc[2] += s0[2] * w; acc[3] += s0[3] * w;
                        acc[4] += s1[0] * w; acc[5] += s1[1] * w; acc[6] += s1[2] * w; acc[7] += s1[3] * w; acc[8] += s2[0] * w; } }
                LDS_WAIT(); asm volatile("" ::: "memory");
            }
            if (actv) {
#pragma unroll
                for (int sq = 0; sq < 9; ++sq) *(LAS f32x4*)(RED + ((F.wave * 2 + sub) * 9 + sq) * 96 + 4 * c4) = acc[sq]; }
            __syncthreads();
            for (int t = F.tid; t < 9 * 96; t += 512) { const int sq = t / 96, c = t - 96 * sq; float sum = ap->b_ada[n0 + c];
#pragma unroll
                for (int p = 0; p < 16; ++p) sum += RED[(p * 9 + sq) * 96 + c];
                mod[(size_t)sq * (6 * DM) + n0 + c] = sum; }
            __syncthreads();
        }
    }
    __syncthreads();
    LAS float* scr = (LAS float*)(F.lds + F.wave * TR_SCR);
    const int gw = F.vcu * 8 + F.wave, NGW = F.G * 8;
    constexpr int I_INA = 64 * (NINA / 64), I_AMX = 64 * (NINB / 64), I_O = 64 * 64;
    unsigned* camax = (unsigned*)(ws + WS_CAMAX);
    for (int it = gw; it < I_INA; it += NGW) { const int nb = NINA / 64, kb = it / nb, nbk = it - kb * nb; transpose_item<false>(ap->w_in, DM, NIN, (bf16*)(ws + WS_WIN), kb * 64, inA_logical(nbk * 64), nbk * 64, scr, F.lane); }
    if (T8 < NT_UP) for (int it = (gw + 1536) % NGW; it < 64 * (NT_UP - T8) * 4; it += NGW) { const int nb = (NT_UP - T8) * 4, kb = it / nb, np0 = T8 * 256 + (it - kb * nb) * 64; transpose_item<false>(ap->w_up, DM, NUP, (bf16*)(ws + WS_WUP), kb * 64, up_logical(np0), np0, scr, F.lane); }
    if (T8 > 0) { unsigned* camax2 = (unsigned*)(ws + WS_CAMAX2);
        for (int it = (gw + 1536) % NGW; it < (64 / AMX_STRIDE) * T8 * 4; it += NGW) { const int nb = T8 * 4, kb = (it / nb) * AMX_STRIDE, np0 = (it - (it / nb) * nb) * 64; if (UP_ROT) amax_item_h(false, ap->w_up, NUP, kb * 64, up_logical(np0), np0, camax2, F.lane); else amax_item(false, ap->w_up, NUP, kb * 64, up_logical(np0), np0, camax2, F.lane); } }
    for (int it = gw; it < I_O; it += NGW) { const int kb = it >> 6, nbk = it & 63; transpose_item<false>(ap->w_o, DM, DM, (bf16*)(ws + WS_WO), kb * 64, nbk * 64, nbk * 64, scr, F.lane); }
    { unsigned* camax3 = (unsigned*)(ws + WS_CAMAX3);
        for (int it = (gw + 512) % NGW; it < ((DFF / 64 + AMX_STRIDE - 1) / AMX_STRIDE) * 64; it += NGW) { const int kb = (it >> 6) * AMX_STRIDE, nbk = it & 63; amax_item_h(false, ap->w_down, DM, kb * 64, nbk * 64, nbk * 64, camax3, F.lane); } }
    for (int it = gw; it < I_AMX / AMX_STRIDE; it += NGW) { const int nb = NINB / 64, kb = (it / nb) * AMX_STRIDE, nbk = it - (it / nb) * nb;
        amax_item_h(nbk < 80, ap->w_in, NIN, kb * 64, inB_logical(nbk * 64), nbk * 64, camax, F.lane); }
}

__device__ __forceinline__ void tail_copy_wdown(LAS unsigned char* lds_, int nwg) {
    const ArgsP ap = kargs(); Frame F = make_frame(lds_);
    const int G = F.G, extra = nwg % G, bx = blockIdx.x;
    if (extra == 0 || bx < extra) return;
    const int nb = G - extra, gw = (bx - extra) * 8 + F.wave, NGW = nb * 8;
    LAS float* scr = (LAS float*)(F.lds + F.wave * TR_SCR);
    for (int it = gw; it < (DFF / 64) * 64; it += NGW) { const int kb = it >> 6, nbk = it & 63; transpose_item_i8_h(false, ap->w_down, DFF, DM, (signed char*)(ap->ws + WS_WDN), kb * 64, nbk * 64, nbk * 64, (const unsigned*)(ap->ws + WS_CAMAX3), (float*)(ap->ws + WS_SWD), F.lane); }
}

__device__ __forceinline__ void v8t_pass(LAS unsigned char* lds_) {
    const ArgsP ap = kargs(); Frame F = make_frame(lds_);
    const bf16* V = (const bf16*)(ap->ws + WS_V); unsigned char* V8T = ap->ws + WS_V8T;
    LAS unsigned char* T = F.lds + F.wave * TR_SCR;
    const int gw = F.vcu * 8 + F.wave, NGW = F.G * 8;
    for (int it = gw; it < 8 * (MROWS / 64); it += NGW) {
        const int kvh = it & 7, tile = it >> 3;
        const bf16* src = V + (size_t)tile * 64 * KVD + kvh * 128 + (F.lane & 15) * 8;
#pragma unroll 4
        for (int ps = 0; ps < 16; ++ps) {
            const int kap = 4 * ps + (F.lane >> 4);
            const u32x4 w = *(const u32x4*)(src + (size_t)kap * KVD);
            const int pos = 32 * ((kap >> 2) & 1) + 16 * (kap >> 5) + (kap & 3) + 4 * ((kap & 31) >> 3);
            const int lo = att::cvt4_fp8(att::bflo(w.x), att::bfhi(w.x), att::bflo(w.y), att::bfhi(w.y)), hi4 = att::cvt4_fp8(att::bflo(w.z), att::bfhi(w.z), att::bflo(w.w), att::bfhi(w.w));
            LAS unsigned char* t = T + ((F.lane & 15) * 8) * 80 + pos;
            t[0] = (unsigned char)lo; t[80] = (unsigned char)(lo >> 8); t[160] = (unsigned char)(lo >> 16); t[240] = (unsigned char)(lo >> 24);
            t[320] = (unsigned char)hi4; t[400] = (unsigned char)(hi4 >> 8); t[480] = (unsigned char)(hi4 >> 16); t[560] = (unsigned char)(hi4 >> 24);
        }
        LDS_WAIT(); asm volatile("" ::: "memory");
        unsigned char* dst = V8T + (size_t)(kvh * (MROWS / 64) + tile) * 8192;
#pragma unroll
        for (int q = 0; q < 8; ++q) { const int id = q * 64 + F.lane; *(u32x4*)(dst + id * 16) = *(const LAS u32x4*)(T + (id >> 2) * 80 + (id & 3) * 16); }
        LDS_WAIT(); asm volatile("" ::: "memory");
    }
}

__device__ __forceinline__ void phase_rows_u(LAS unsigned char* lds_) {
    const ArgsP ap = kargs(); Frame F = make_frame(lds_);
    const int gw = F.vcu * 8 + F.wave, NGW = F.G * 8; const float* mod = (const float*)(ap->ws + WS_MOD); bf16* U = (bf16*)(ap->ws + WS_U);
    unsigned char* U8 = (unsigned char*)ap->out + OUT_U8; float* SU = (float*)(ap->ws + WS_SU);
    {
        LAS float* scr = (LAS float*)(F.lds + F.wave * TR_SCR); const unsigned* camax = (const unsigned*)(ap->ws + WS_CAMAX); float* swp = (float*)(ap->ws + WS_SWP); signed char* W8 = (signed char*)(ap->ws + WS_W8);
        for (int it = gw; it < 64 * (NINB / 64); it += NGW) { const int nb = NINB / 64, kb = it / nb, nbk = it - kb * nb;
            transpose_item_i8_h(nbk < 80, ap->w_in, DM, NIN, W8, kb * 64, inB_logical(nbk * 64), nbk * 64, camax, swp, F.lane); }        if (T8 > 0) { const unsigned* camax2 = (const unsigned*)(ap->ws + WS_CAMAX2); float* swpu = (float*)(ap->ws + WS_SWPU); signed char* W8U = (signed char*)(ap->ws + WS_WUP);
            for (int it = (gw + 1024) % NGW; it < 64 * T8 * 4; it += NGW) { const int nb = T8 * 4, kb = it / nb, np0 = (it - kb * nb) * 64; if (UP_ROT) transpose_item_i8_h(false, ap->w_up, DM, NUP, W8U, kb * 64, up_logical(np0), np0, camax2, swpu, F.lane); else transpose_item_i8(false, ap->w_up, DM, NUP, W8U, kb * 64, up_logical(np0), np0, camax2, swpu, scr, F.lane); } }
    }
    for (int m = gw; m < MROWS; m += NGW) {
        const f32x4* xr = (const f32x4*)xrow(ap->xp, ap->xs, m) + F.lane; const float* md = mod + (size_t)seq_of(m) * (6 * DM);
        f32x4 v[16]; float s = 0.f;
#pragma unroll
        for (int j = 0; j < 16; ++j) { v[j] = xr[64 * j]; s += (v[j][0] * v[j][0] + v[j][1] * v[j][1]) + (v[j][2] * v[j][2] + v[j][3] * v[j][3]); }
        const float rstd = 1.0f / sqrtf(wave_sum(s) * (1.0f / DM) + NORM_EPS); float am = 0.f;
#pragma unroll
        for (int j = 0; j < 16; ++j) { const int ch = 4 * (F.lane + 64 * j);
            const f32x4 g = *(const f32x4*)(ap->g_mix_pre + ch), sh = *(const f32x4*)(md + ch), scl = *(const f32x4*)(md + DM + ch);
            const f32x4 u = (v[j] * rstd) * g * (1.0f + scl) + sh;
            u32x2 w; w.x = pk2(u[0], u[1]); w.y = pk2(u[2], u[3]); *(u32x2*)(U + (size_t)m * DM + ch) = w;
            const f32x4 r = fwht64_row(u, F.lane); v[j] = r;
            am = fmaxf(fmaxf(am, fmaxf(fabsf(r[0]), fabsf(r[1]))), fmaxf(fabsf(r[2]), fabsf(r[3]))); }
#pragma unroll
        for (int o = 1; o < 64; o <<= 1) am = fmaxf(am, __shfl_xor(am, o));
        const float inv = am > 0.f ? 127.0f / am : 0.f;
        if (F.lane == 0) SU[m] = am * (1.0f / 127.0f);
#pragma unroll
        for (int j = 0; j < 16; ++j) *(unsigned*)(U8 + (size_t)m * DM + 4 * (F.lane + 64 * j)) = pack_q8s<false>(v[j][0], v[j][1], v[j][2], v[j][3], inv);
    }
}

__device__ __forceinline__ void hadamard_frags(bf16x8 (&HA)[8], int lane) {
    const int fr = lane & 15, fq = lane >> 4;
#pragma unroll
    for (int mi = 0; mi < 4; ++mi)
#pragma unroll
        for (int ks = 0; ks < 2; ++ks) { bf16x8 a;
#pragma unroll
            for (int i = 0; i < 8; ++i) a[i] = (short)((__builtin_popcount((16 * mi + fr) & (32 * ks + 8 * fq + i)) & 1) ? 0xBF80 : 0x3F80);
            HA[2 * mi + ks] = a; }
}
__device__ __forceinline__ void hadamard_rows_mfma(f32x4 (&C)[16], const bf16x8 (&HA)[8], LAS unsigned char* buf, int lane) {
    const int fr = lane & 15, fq = lane >> 4;
    bf16x8 B[8];
#pragma unroll
    for (int nj = 0; nj < 4; ++nj)
#pragma unroll
        for (int ks = 0; ks < 2; ++ks) B[2 * nj + ks] = *(const LAS bf16x8*)(buf + (16 * nj + fr) * 144 + (32 * ks + 8 * fq) * 2);
#pragma unroll
    for (int mi = 0; mi < 4; ++mi)
#pragma unroll
        for (int nj = 0; nj < 4; ++nj) { f32x4 c = {0.f, 0.f, 0.f, 0.f};
            c = __builtin_amdgcn_mfma_f32_16x16x32_bf16(HA[2 * mi], B[2 * nj], c, 0, 0, 0); c = __builtin_amdgcn_mfma_f32_16x16x32_bf16(HA[2 * mi + 1], B[2 * nj + 1], c, 0, 0, 0);
            C[4 * mi + nj] = c; }
}
__device__ __forceinline__ void hadamard_rows_mfma_l(f32x4 (&C)[16], const LAS unsigned char* hl, LAS unsigned char* buf, int lane) {
    const int fr = lane & 15, fq = lane >> 4;
    bf16x8 B[8];
#pragma unroll
    for (int nj = 0; nj < 4; ++nj)
#pragma unroll
        for (int ks = 0; ks < 2; ++ks) B[2 * nj + ks] = *(const LAS bf16x8*)(buf + (16 * nj + fr) * 144 + (32 * ks + 8 * fq) * 2);
#pragma unroll
    for (int mi = 0; mi < 4; ++mi) { const bf16x8 a0 = *(const LAS bf16x8*)(hl + ((2 * mi) * 64 + lane) * 16), a1 = *(const LAS bf16x8*)(hl + ((2 * mi + 1) * 64 + lane) * 16);
#pragma unroll
        for (int nj = 0; nj < 4; ++nj) { f32x4 c = {0.f, 0.f, 0.f, 0.f};
            c = __builtin_amdgcn_mfma_f32_16x16x32_bf16(a0, B[2 * nj], c, 0, 0, 0); c = __builtin_amdgcn_mfma_f32_16x16x32_bf16(a1, B[2 * nj + 1], c, 0, 0, 0);
            C[4 * mi + nj] = c; } }
}
__device__ __forceinline__ void phase_rows_mid(LAS unsigned char* lds_) {
    const ArgsP ap = kargs(); Frame F = make_frame(lds_);
    const float* mod = (const float*)(ap->ws + WS_MOD); bf16* U = (bf16*)(ap->ws + WS_U); const bf16* OUT = (const bf16*)(ap->ws + WS_OUT);
    unsigned char* U28 = ap->ws + WS_U28; float* SU2 = (float*)(ap->ws + WS_SU2);
    LAS f32x4* VL = (LAS f32x4*)F.lds;
    LAS unsigned char* hb = F.lds + 49152 + F.wave * 9216;
    LAS unsigned char* hl = F.lds + 122880;
    if (F.wave == 0) { bf16x8 HA[8]; hadamard_frags(HA, F.lane);
#pragma unroll
        for (int f = 0; f < 8; ++f) *(LAS bf16x8*)(hl + (f * 64 + F.lane) * 16) = HA[f]; }
    const int NSTEP = (MROWS / 8 + F.G - 1) / F.G;
    int cur = -1;
    f32x4 xv[16]; u32x2 ow[16];
    { const int mf = F.vcu * NSTEP * 8 + F.wave; if (mf < MROWS) { const f32x4* xr0 = (const f32x4*)xrow(ap->xp, ap->xs, mf) + F.lane;
#pragma unroll
        for (int j = 0; j < 16; ++j) { ow[j] = *(const u32x2*)(OUT + (size_t)mf * DM + 4 * (F.lane + 64 * j)); xv[j] = xr0[64 * j]; } } }
    for (int i = 0; i < NSTEP; ++i) {
        const int m0 = (F.vcu * NSTEP + i) * 8; if (m0 >= MROWS) break;
        const int m = m0 + F.wave, sq = seq_of(m0), mnx = (i + 1 < NSTEP && m0 + 8 < MROWS) ? m + 8 : m;
        if (sq != cur) {
            __syncthreads();
            const f32x4* md4 = (const f32x4*)(mod + (size_t)sq * (6 * DM)); const f32x4* gpo = (const f32x4*)ap->g_mix_post; const f32x4* gfp = (const f32x4*)ap->g_ffn_pre;
            for (int c = F.tid; c < 1024; c += 512) { VL[c] = md4[2 * 1024 + c] * gpo[c]; VL[1024 + c] = gfp[c] * (1.0f + md4[4 * 1024 + c]); VL[2048 + c] = md4[3 * 1024 + c]; }
            __syncthreads(); cur = sq;
        }
        f32x4 h[16]; float s = 0.f;
#pragma unroll
        for (int j = 0; j < 16; ++j) { const u32x2 w = ow[j]; h[j] = (f32x4){bflo(w.x), bfhi(w.x), bflo(w.y), bfhi(w.y)};
            s += (h[j][0] * h[j][0] + h[j][1] * h[j][1]) + (h[j][2] * h[j][2] + h[j][3] * h[j][3]); }
#pragma unroll
        for (int j = 0; j < 16; ++j) ow[j] = *(const u32x2*)(OUT + (size_t)mnx * DM + 4 * (F.lane + 64 * j));
        const float rstd1 = 1.0f / sqrtf(wave_sum(s) * (1.0f / DM) + NORM_EPS);
        float s2 = 0.f;
#pragma unroll
        for (int j = 0; j < 16; ++j) { const int c = F.lane + 64 * j;
            h[j] = xv[j] + VL[c] * (h[j] * rstd1);
            { u32x2 hw; hw.x = pk2(h[j][0], h[j][1]); hw.y = pk2(h[j][2], h[j][3]); *(u32x2*)(U + (size_t)m * DM + 4 * c) = hw; }
            s2 += (h[j][0] * h[j][0] + h[j][1] * h[j][1]) + (h[j][2] * h[j][2] + h[j][3] * h[j][3]); }
        { const f32x4* xrn = (const f32x4*)xrow(ap->xp, ap->xs, mnx) + F.lane;
#pragma unroll
          for (int j = 0; j < 16; ++j) xv[j] = xrn[64 * j]; }
        const float rstd2 = 1.0f / sqrtf(wave_sum(s2) * (1.0f / DM) + NORM_EPS); float am = 0.f;
#pragma unroll
        for (int j = 0; j < 16; ++j) { const int c = F.lane + 64 * j;
            const f32x4 u = (h[j] * rstd2) * VL[1024 + c] + VL[2048 + c];
            u32x2 w; w.x = pk2(u[0], u[1]); w.y = pk2(u[2], u[3]);
            *(LAS u32x2*)(hb + (4 * j + (F.lane >> 4)) * 144 + (F.lane & 15) * 8) = w; }
        LDS_WAIT();
        f32x4 C[16]; hadamard_rows_mfma_l(C, hl, hb, F.lane);
#pragma unroll
        for (int t = 0; t < 16; ++t) am = fmaxf(fmaxf(am, fmaxf(fabsf(C[t][0]), fabsf(C[t][1]))), fmaxf(fabsf(C[t][2]), fabsf(C[t][3])));
#pragma unroll
        for (int o = 1; o < 64; o <<= 1) am = fmaxf(am, __shfl_xor(am, o));
        const float inv = am > 0.f ? 127.0f / am : 0.f;
        if (F.lane == 0) SU2[m] = am * (1.0f / 127.0f);
        LDS_WAIT();
#pragma unroll
        for (int mi = 0; mi < 4; ++mi)
#pragma unroll
            for (int nj = 0; nj < 4; ++nj) { const f32x4 c = C[4 * mi + nj];
                *(LAS unsigned*)(hb + (16 * nj + (F.lane & 15)) * 64 + 16 * mi + 4 * (F.lane >> 4)) = pack_q8s<false>(c[0], c[1], c[2], c[3], inv); }
        LDS_WAIT();
#pragma unroll
        for (int q = 0; q < 4; ++q) *(u32x4*)(U28 + (size_t)m * DM + q * 1024 + F.lane * 16) = *(const LAS u32x4*)(hb + q * 1024 + F.lane * 16);
        LDS_WAIT();
    }
    __syncthreads();
}

__device__ __forceinline__ void phase_fixup(LAS unsigned char* lds_) {
    const ArgsP ap = kargs(); Frame F = make_frame(lds_);
    const int gw = F.vcu * 8 + F.wave, NGW = F.G * 8; const float* SB = (const float*)(ap->ws + WS_SB); bf16* ACT = (bf16*)(ap->ws + WS_ACT);
    constexpr int NCB = 22, NSTRIP = MROWS / 128;
    for (int it = gw; it < NSTRIP * 2 * NCB; it += NGW) {
        const int cb = it % NCB, sl = it / NCB, strip = sl >> 1, last = sl & 1, f0 = cb * 512 + F.lane * 8;
        if (f0 >= DFF) continue;
        const int row = strip * 128 + (last ? 127 : 0), seqlen = row < MP ? SEQP : SEQS, t = row < MP ? (row & (SEQP - 1)) : (row - MP);
        const bool has_nb = last ? (t != seqlen - 1) : (t != 0);
        const int pc = 256 * (f0 >> 7) + (f0 & 127);
        const float* part = SB + ((size_t)strip * 4 + (last ? 3 : 2)) * NUP + pc;
        const float* nb = SB + ((size_t)(last ? strip + 1 : strip - 1) * 4 + (last ? 0 : 1)) * NUP + pc;
        const float* wrow = ap->ffn_conv_w + (last ? 2 * NUP : 0);
        float ov[8];
#pragma unroll
        for (int h = 0; h < 2; ++h) {
            const f32x4 pa = *(const f32x4*)(part + 4 * h), pb = *(const f32x4*)(part + 128 + 4 * h);
            f32x4 na = (f32x4){0.f, 0.f, 0.f, 0.f}, nbv = na;
            if (has_nb) { na = *(const f32x4*)(nb + 4 * h); nbv = *(const f32x4*)(nb + 128 + 4 * h); }
            const f32x4 wa = *(const f32x4*)(wrow + f0 + 4 * h), wb = *(const f32x4*)(wrow + DFF + f0 + 4 * h);
            const f32x4 za = pa + wa * na, zb = pb + wb * nbv;
#pragma unroll
            for (int e = 0; e < 4; ++e) ov[4 * h + e] = za[e] * __builtin_amdgcn_rcpf(1.0f + __builtin_amdgcn_exp2f(-1.4426950408889634f * za[e])) * zb[e];
        }
        u32x4 w; w.x = pk2(ov[0], ov[1]); w.y = pk2(ov[2], ov[3]); w.z = pk2(ov[4], ov[5]); w.w = pk2(ov[6], ov[7]);
        *(u32x4*)(ACT + (size_t)row * DFF + f0) = w;
    }
}

__device__ __forceinline__ void phase_actq(LAS unsigned char* lds_) {
    const ArgsP ap = kargs(); Frame F = make_frame(lds_);
    const int gw = F.vcu * 8 + F.wave, NGW = F.G * 8; const bf16* ACT = (const bf16*)(ap->ws + WS_ACT); unsigned char* A8 = ap->ws + WS_ACT8; float* SA = (float*)(ap->ws + WS_SA);
    constexpr int NBLK = DFF / 64;
    bf16x8 HA[8]; hadamard_frags(HA, F.lane);
    LAS unsigned char* hb = F.lds + F.wave * 4096;
    const int fr = F.lane & 15, fq = F.lane >> 4;
    bf16x8 BB[24];
#define AQ_LOADB(ROW, CH) do { _Pragma("unroll") for (int nj = 0; nj < 4; ++nj) { int blk = 64 * (CH) + 16 * nj + fr; blk = blk < NBLK ? blk : NBLK - 1; \
        _Pragma("unroll") for (int ks = 0; ks < 2; ++ks) BB[8 * (CH) + 2 * nj + ks] = *(const bf16x8*)((ROW) + blk * 64 + 32 * ks + 8 * fq); } } while (0)
#define AQ_MMA(CH) do { _Pragma("unroll") for (int mi = 0; mi < 4; ++mi) _Pragma("unroll") for (int nj = 0; nj < 4; ++nj) { f32x4 c = {0.f, 0.f, 0.f, 0.f}; \
        c = __builtin_amdgcn_mfma_f32_16x16x32_bf16(HA[2 * mi], BB[8 * (CH) + 2 * nj], c, 0, 0, 0); c = __builtin_amdgcn_mfma_f32_16x16x32_bf16(HA[2 * mi + 1], BB[8 * (CH) + 2 * nj + 1], c, 0, 0, 0); C[4 * mi + nj] = c; } } while (0)
    if (gw < MROWS) { const bf16* row0 = ACT + (size_t)gw * DFF; AQ_LOADB(row0, 0); AQ_LOADB(row0, 1); AQ_LOADB(row0, 2); }
    for (int m = gw; m < MROWS; m += NGW) {
        const bf16* rown = ACT + (size_t)((m + NGW < MROWS) ? m + NGW : m) * DFF;
        float am = 0.f;
#pragma unroll
        for (int ch = 0; ch < 3; ++ch) { f32x4 C[16]; AQ_MMA(ch);
#pragma unroll
            for (int t = 0; t < 16; ++t) am = fmaxf(fmaxf(am, fmaxf(fabsf(C[t][0]), fabsf(C[t][1]))), fmaxf(fabsf(C[t][2]), fabsf(C[t][3]))); }
#pragma unroll
        for (int o = 1; o < 64; o <<= 1) am = fmaxf(am, __shfl_xor(am, o));
        const float inv = am > 0.f ? 127.0f / am : 0.f;
        if (F.lane == 0) SA[m] = am * (1.0f / 127.0f);
#pragma unroll
        for (int ch = 0; ch < 3; ++ch) { f32x4 C[16]; AQ_MMA(ch);
#pragma unroll
            for (int mi = 0; mi < 4; ++mi)
#pragma unroll
                for (int nj = 0; nj < 4; ++nj) { const f32x4 c = C[4 * mi + nj];
                    *(LAS unsigned*)(hb + (16 * nj + fr) * 64 + 16 * mi + 4 * fq) = pack_q8s<false>(c[0], c[1], c[2], c[3], inv); }
            AQ_LOADB(rown, ch);
            LDS_WAIT();
            const int nbytes = (ch < 2 ? 64 : NBLK - 128) * 64;
#pragma unroll
            for (int q = 0; q < 4; ++q) { const int off = q * 1024 + F.lane * 16; if (off < nbytes) *(u32x4*)(A8 + (size_t)m * DFF + ch * 4096 + off) = *(const LAS u32x4*)(hb + off); }
            LDS_WAIT();
        }
    }
#undef AQ_LOADB
#undef AQ_MMA
}

__device__ __forceinline__ void phase_rows_final(LAS unsigned char* lds_) {
    const ArgsP ap = kargs(); Frame F = make_frame(lds_);
    const float* mod = (const float*)(ap->ws + WS_MOD); const bf16* Y = (const bf16*)(ap->ws + WS_Y); const bf16* H1 = (const bf16*)(ap->ws + WS_U);
    LAS f32x4* VL = (LAS f32x4*)F.lds;
    const int NSTEP = (MROWS / 8 + F.G - 1) / F.G;
    int cur = -1;
    u32x2 yw[16], hw[16];
    { const int mf = F.vcu * NSTEP * 8 + F.wave; if (mf < MROWS) {
#pragma unroll
        for (int j = 0; j < 16; ++j) { yw[j] = *(const u32x2*)(Y + (size_t)mf * DM + 4 * (F.lane + 64 * j)); hw[j] = *(const u32x2*)(H1 + (size_t)mf * DM + 4 * (F.lane + 64 * j)); } } }
    for (int i = 0; i < NSTEP; ++i) {
        const int m0 = (F.vcu * NSTEP + i) * 8; if (m0 >= MROWS) break;
        const int m = m0 + F.wave, sq = seq_of(m0), mnx = (i + 1 < NSTEP && m0 + 8 < MROWS) ? m + 8 : m;
        if (sq != cur) {
            __syncthreads();
            const f32x4* md4 = (const f32x4*)(mod + (size_t)sq * (6 * DM)); const f32x4* gpo = (const f32x4*)ap->g_ffn_post;
            for (int c = F.tid; c < 1024; c += 512) VL[c] = md4[5 * 1024 + c] * gpo[c];
            __syncthreads(); cur = sq;
        }
        f32x4 h[16], r[16]; float s = 0.f;
#pragma unroll
        for (int j = 0; j < 16; ++j) { const u32x2 w = yw[j]; h[j] = (f32x4){bflo(w.x), bfhi(w.x), bflo(w.y), bfhi(w.y)}; const u32x2 q = hw[j]; r[j] = (f32x4){bflo(q.x), bfhi(q.x), bflo(q.y), bfhi(q.y)};
            s += (h[j][0] * h[j][0] + h[j][1] * h[j][1]) + (h[j][2] * h[j][2] + h[j][3] * h[j][3]); }
#pragma unroll
        for (int j = 0; j < 16; ++j) { yw[j] = *(const u32x2*)(Y + (size_t)mnx * DM + 4 * (F.lane + 64 * j)); hw[j] = *(const u32x2*)(H1 + (size_t)mnx * DM + 4 * (F.lane + 64 * j)); }
        const float rstd = 1.0f / sqrtf(wave_sum(s) * (1.0f / DM) + NORM_EPS);
#pragma unroll
        for (int j = 0; j < 16; ++j) { const int c = F.lane + 64 * j; *(f32x4*)(ap->out + (size_t)m * DM + 4 * c) = r[j] + VL[c] * (h[j] * rstd); }
    }
    __syncthreads();
}

constexpr int NPHASE = 12;
__global__ void __launch_bounds__(512, 2) fwd_kernel(Args args) {
    extern __shared__ __attribute__((aligned(16))) unsigned char lds[];
    LAS unsigned char* L = (LAS unsigned char*)lds;
    volatile LAS unsigned* MISC = (volatile LAS unsigned*)(L + LDSCTL_OFF);
    for (int u = threadIdx.x; u < (LDS_BYTES - LDSCTL_OFF) / 4; u += 512) ((LAS unsigned*)(L + LDSCTL_OFF))[u] = 0u;
    __syncthreads();
    XcdBarrier bar; bar.bar = (unsigned*)(args.ws + WS_CTL) + CW_BAR; bar.x = 0; bar.st = nullptr;
#if !MK_PER_PHASE
    bar = xcd_barrier_post((unsigned*)(args.ws + WS_CTL) + CW_BAR, MISC + 8);
#endif
#ifndef PH_MASK
#define PH_MASK 0xffff
#endif
#if MK_PER_PHASE
    const int lo = args.ph_lo, hi = args.ph_hi;
#define IN(k) (((PH_MASK >> (k)) & 1) && lo <= (k) && (k) < hi)
#define SEAM(k) do { } while (0)
#else
#define IN(k) ((PH_MASK >> (k)) & 1)
#define SEAM(k) xcd_barrier(bar)
#endif
    if (IN(0)) { phase0(L); } SEAM(0);
    if (IN(1)) { phase_rows_u(L); } SEAM(1);
    if (IN(2)) {
        const ArgsP ap = kargs(); unsigned char* ws = ap->ws; const int G = gridDim.x; unsigned char* ob = (unsigned char*)ap->out;
        pg8::Gemm g{(const bf16*)(ob + OUT_U8), (const bf16*)(ws + WS_W8), MROWS, NINB, DM / 2}; pg8::StaticOrder S; S.init(MROWS, NINB, G, (int)blockIdx.x);
        pg8::EpiInB E{ws, ap->g_q, ap->g_k, (LAS float*)(L + XS_OFF)};
        pg8::gemm_phase<pg8::EpiInB, pg8::StaticOrder, PG8_ALIGN, PG8_SP2, PG8_BAL>(L, g, S, E);
    } SEAM(2);
    if (IN(3)) {
        v8t_pass(L); __syncthreads();
        const ArgsP ap = kargs(); unsigned char* ws = ap->ws; const int G = gridDim.x;
        pg8::Gemm g{(const bf16*)(ws + WS_U), (const bf16*)(ws + WS_WIN), MROWS, NINA, DM}; pg8::StaticOrder S; S.init(MROWS, NINA, G, (int)blockIdx.x);
        pg8::EpiInA E{(bf16*)(ws + WS_P)};
        pg8::gemm_phase<pg8::EpiInA, pg8::StaticOrder, PG8_ALIGN, PG8_SP2, PG8_BAL>(L, g, S, E);
    } SEAM(3);
    if (IN(4)) {
        const ArgsP ap = kargs(); unsigned char* ws = ap->ws; const int G = gridDim.x;
        const att::Merge mg{(const bf16*)(ws + WS_SGA), (const bf16*)(ws + WS_GBS), (const bf16*)(ws + WS_P), ap->conv_w, ap->conv_b};
        const signed char* Q = (const signed char*)(ws + WS_Q); bf16* MGo = (bf16*)(ws + WS_U); const signed char* Kb = (const signed char*)(ws + WS_K); const unsigned char* Vb = (const unsigned char*)(ws + WS_V8T);
        int atid = threadIdx.x; asm volatile("" : "+v"(atid));
        for (int ui = blockIdx.x; ui < 3072; ui += G) {
            int kvh, qb, gq, seq, seqrow0;
            if (ui < 1024) { kvh = ui & 7; qb = (ui >> 3) & 31; gq = ui >> 8; seq = SEQS; seqrow0 = MP; }
            else { const int p = ui - 1024, loc = (p >> 3) & 31; kvh = p & 7; gq = loc >> 3; qb = loc & 7; seq = SEQP; seqrow0 = (p >> 8) * SEQP; }
            const int h = kvh * 4 + gq; const size_t row0 = (size_t)seqrow0 + (size_t)qb * 256;
            att::attn_unit(Q + row0 * DM + h * 128, MGo + row0 * DM + h * 128, Kb + (size_t)seqrow0 * KVD + kvh * 128, Vb + (size_t)(kvh * (MROWS / 64) + (seqrow0 >> 6)) * 8192, seq, qb * 256, row0, h, mg, (char*)lds, (char*)lds + ATT_SCR_OFF, atid);
        }
    } SEAM(4);
    if (IN(5)) {
        unsigned char* ws = kargs()->ws; const int G = gridDim.x;
        pg8::Gemm g{(const bf16*)(ws + WS_U), (const bf16*)(ws + WS_WO), MROWS, DM, DM}; pg8::StaticOrder S; S.init(MROWS, DM, G, (int)blockIdx.x);
        pg8::EpiBf16 E{(bf16*)(ws + WS_OUT), DM};
        pg8::gemm_phase<pg8::EpiBf16, pg8::StaticOrder, PG8_ALIGN, PG8_SP2, PG8_BAL>(L, g, S, E);
    } SEAM(5);
    if (IN(6)) { phase_rows_mid(L); } SEAM(6);
    if (IN(7)) {
        if (T8 > 0) {
            const ArgsP ap = kargs(); unsigned char* ws = ap->ws; const int G = gridDim.x;
            pg8::Gemm g{(const bf16*)(ws + WS_U28), (const bf16*)(ws + WS_WUP), MROWS, T8 * 256, DM / 2}; pg8::StaticOrder S; S.init(MROWS, T8 * 256, G, (int)blockIdx.x);
            pg8::EpiUp<true> E{(bf16*)(ws + WS_ACT), (float*)(ws + WS_SB), ap->ffn_conv_w, ap->ffn_conv_b, (const float*)(ws + WS_SU2), (const float*)(ws + WS_SWPU), 0};
            pg8::gemm_phase<pg8::EpiUp<true>, pg8::StaticOrder, PG8_ALIGN, PG8_SP2, PG8_BAL, true>(L, g, S, E);
        }
        if (T8 < NT_UP) {
            const ArgsP ap = kargs(); unsigned char* ws = ap->ws; const int G = gridDim.x;
            pg8::Gemm g{(const bf16*)(ws + WS_U), (const bf16*)(ws + WS_WUP) + (size_t)T8 * 256 * DM, MROWS, (NT_UP - T8) * 256, DM}; pg8::StaticOrder S; S.init(MROWS, (NT_UP - T8) * 256, G, (int)blockIdx.x);
            pg8::EpiUp<false> E{(bf16*)(ws + WS_ACT), (float*)(ws + WS_SB), ap->ffn_conv_w, ap->ffn_conv_b, nullptr, nullptr, T8};
            pg8::gemm_phase<pg8::EpiUp<false>, pg8::StaticOrder, PG8_ALIGN, PG8_SP2, PG8_BAL>(L, g, S, E);
        }
        tail_copy_wdown(L, (MROWS / 256) * (T8 < NT_UP ? NT_UP - T8 : T8));
    } SEAM(7);
    if (IN(8)) { phase_fixup(L); } SEAM(8);
    if (IN(9)) { phase_actq(L); } SEAM(9);
    if (IN(10)) {
        unsigned char* ws = kargs()->ws; const int G = gridDim.x;
        pg8::Gemm g{(const bf16*)(ws + WS_ACT8), (const bf16*)(ws + WS_WDN), MROWS, DM, DFF / 2}; pg8::StaticOrder S; S.init(MROWS, DM, G, (int)blockIdx.x);
        pg8::EpiI8Bf16 E{(bf16*)(ws + WS_Y), DM, (const float*)(ws + WS_SA), (const float*)(ws + WS_SWD)};
        pg8::gemm_phase<pg8::EpiI8Bf16, pg8::StaticOrder, PG8_ALIGN, PG8_SP2, PG8_BAL>(L, g, S, E);
    } SEAM(10);
    if (IN(11)) { phase_rows_final(L); }
#undef IN
#undef SEAM
}

extern "C" void kernel_launch(void* const* d_in, const int* in_sizes, int n_in, void* d_out, int out_size, void* d_ws, size_t ws_size, hipStream_t stream) {
    static int grid = 0;
    if (grid == 0) {
        if (n_in != 20 || in_sizes[0] != MP * DM || in_sizes[1] != MS * DM || out_size != MROWS * DM || ws_size < WS_END) {
            fprintf(stderr, "kernel_launch: shape/workspace mismatch: n_in %d in0 %d in1 %d out %d ws %zu (need %zu); nothing launched\n", n_in, n_in > 0 ? in_sizes[0] : -1, n_in > 1 ? in_sizes[1] : -1, out_size, ws_size, (size_t)WS_END); grid = -1; return; }
        int dev = 0, cus = 0, per_cu = 0;
        if (hipGetDevice(&dev) != hipSuccess || hipDeviceGetAttribute(&cus, hipDeviceAttributeMultiprocessorCount, dev) != hipSuccess) { fprintf(stderr, "kernel_launch: device query failed\n"); grid = -1; return; }
        if (hipFuncSetAttribute((const void*)fwd_kernel, hipFuncAttributeMaxDynamicSharedMemorySize, LDS_BYTES) != hipSuccess) { fprintf(stderr, "kernel_launch: hipFuncSetAttribute failed\n"); grid = -1; return; }
        if (hipOccupancyMaxActiveBlocksPerMultiprocessor(&per_cu, (const void*)fwd_kernel, 512, LDS_BYTES) != hipSuccess || per_cu < 1)
            fprintf(stderr, "kernel_launch: note: occupancy query reports %d workgroups per CU\n", per_cu);
        (void)hipGetLastError();
        grid = cus;
    }
    if (grid < 0) return;
    if (hipMemsetAsync((char*)d_ws + WS_CTL, 0, ZERO_BYTES, stream) != hipSuccess) { fprintf(stderr, "kernel_launch: memset failed\n"); return; }
    Args a{};
    const float** pp = (const float**)&a;
    for (int i = 0; i < 20; ++i) pp[i] = (const float*)d_in[i];
    a.out = (float*)d_out; a.ws = (unsigned char*)d_ws;
#if MK_PER_PHASE
    for (int p = 0; p < NPHASE; ++p) { a.ph_lo = p; a.ph_hi = p + 1; hipLaunchKernelGGL(fwd_kernel, dim3(grid), dim3(512), LDS_BYTES, stream, a); }
#else
    a.ph_lo = 0; a.ph_hi = NPHASE; hipLaunchKernelGGL(fwd_kernel, dim3(grid), dim3(512), LDS_BYTES, stream, a);
#endif
    const hipError_t le = hipPeekAtLastError();
    if (le != hipSuccess) fprintf(stderr, "kernel_launch: launch failed: %s\n", hipGetErrorName(le));
}
```

```cpp
#include <hip/hip_runtime.h>
#include <cstdio>
#include <cstdint>
#include <type_traits>

#ifndef MK_PER_PHASE
#define MK_PER_PHASE 0
#endif

#define GAS __attribute__((address_space(1)))
#define LAS __attribute__((address_space(3)))
typedef unsigned short bf16;
typedef short bf16x8 __attribute__((ext_vector_type(8)));
typedef short s16x4 __attribute__((ext_vector_type(4)));
typedef float f32x4 __attribute__((ext_vector_type(4)));
typedef float f32x16 __attribute__((ext_vector_type(16)));
typedef unsigned u32x4 __attribute__((ext_vector_type(4)));
typedef unsigned u32x2 __attribute__((ext_vector_type(2)));
typedef int i32x4 __attribute__((ext_vector_type(4)));

constexpr int DM = 4096, MP = 16384, MS = 8192, MROWS = MP + MS;
constexpr int SEQP = 2048, SEQS = 8192, NSEQ = 9;
constexpr int NIN = 26624, NUP = 22016, DFF = 11008, KVD = 1024;
constexpr int NINA = 8192, NINB = 18432;
#ifndef UP_T8
#define UP_T8 86
#endif
#ifndef UP_ROT
#define UP_ROT 1
#endif
constexpr int AMX_STRIDE = 8; constexpr float AMX_SAFETY = 1.2f;
constexpr int T8 = UP_T8, NT_UP = NUP / 256;
constexpr float NORM_EPS = 1e-6f;

constexpr size_t MiB = 1u << 20;
constexpr size_t WS_CTL = 0, WS_MOD = 1 * MiB, ZERO_BYTES = 2 * MiB;
constexpr size_t WS_CAMAX = 768 * 1024;
constexpr size_t WS_ROPE = 2 * MiB;
constexpr size_t WS_CAMAX3 = 512 * 1024;
constexpr size_t WS_CAMAX2 = WS_MOD + (size_t)NSEQ * 6 * DM * 4;
constexpr size_t WS_SWP = WS_ROPE + 786432, WS_SU = WS_ROPE + 131072, WS_SU2 = WS_ROPE + 262144, WS_SWPU = WS_ROPE + 393216, WS_SWD = WS_ROPE + 524288, WS_SA = WS_ROPE + 655360;
constexpr size_t WS_W8 = 99 * MiB;
constexpr size_t WS_WIN = 3 * MiB, WS_WO = 211 * MiB, WS_WUP = 243 * MiB, WS_WDN = 415 * MiB;
constexpr size_t WS_ACT8 = 3 * MiB;
constexpr size_t WS_U = 501 * MiB;
constexpr size_t WS_BIG = 693 * MiB;
constexpr size_t WS_Q = WS_BIG, WS_K = WS_BIG + 192 * MiB, WS_V = WS_BIG + 240 * MiB, WS_P = WS_BIG + 288 * MiB, WS_GBS = WS_BIG + 480 * MiB, WS_SGA = WS_BIG + 672 * MiB;
constexpr size_t WS_V8T = WS_K + 24 * MiB;
constexpr size_t WS_OUT = WS_P;
constexpr size_t WS_ACT = WS_BIG, WS_SB = WS_BIG + 516 * MiB, WS_Y = WS_BIG + 600 * MiB, WS_U28 = WS_Y;
constexpr size_t WS_END = WS_BIG + 864 * MiB;
static_assert(T8 == NT_UP, "h1 lives (bf16) where the bf16 copy of u2 would go: all up-projection tiles must be int8");
static_assert(WS_ACT8 + (size_t)MROWS * DFF <= WS_WDN && WS_SA + (size_t)MROWS * 4 <= WS_WIN && WS_CAMAX2 + (size_t)NUP * 4 <= ZERO_BYTES && WS_CAMAX3 + (size_t)DM * 4 <= WS_CAMAX && WS_CAMAX + (size_t)NINB * 4 <= WS_MOD && WS_SWP + (size_t)NINB * 4 <= WS_WIN && WS_SWPU + (size_t)NUP * 4 <= WS_WIN && WS_WIN + (size_t)NINA * DM * 2 <= WS_W8 && WS_W8 + (size_t)NINB * DM <= WS_WO && WS_WO + (size_t)DM * DM * 2 <= WS_WUP && WS_WUP + (size_t)NUP * DM * 2 <= WS_WDN && WS_WDN + (size_t)DM * DFF * 2 <= WS_U, "weights map");
static_assert(WS_U + (size_t)MROWS * DM * 2 <= WS_BIG && WS_ACT + (size_t)MROWS * DFF * 2 <= WS_SB && WS_SB + (size_t)(MROWS / 128) * 4 * NUP * 4 <= WS_Y && WS_Y + (size_t)MROWS * DM * 2 <= WS_END && WS_SGA + (size_t)MROWS * DM * 2 <= WS_END, "act map");
constexpr size_t OUT_U8 = 0;
constexpr int CW_BAR = 4096;

constexpr int LDS_BYTES = 147456;
constexpr int XS_OFF = 135168;
constexpr int ATT_SCR_OFF = 133120;
constexpr int LDSCTL_OFF = 146432;
constexpr int TR_SCR = 16640;

namespace pg8 {
#define PG8_LAS __attribute__((address_space(3)))
typedef unsigned short bf16_t;
constexpr int BM = 256, BK = 64, HALF = 128, HTB = HALF * BK * 2, STAGE_BYTES = 8 * HTB, NXCD = 8, WGM = 8;
__host__ __device__ __forceinline__ int lds_byte(int r, int c) { const int st = (r >> 4) * 2 + (c >> 5), rr = r & 15, cc = c & 31, ob = rr * 64 + cc * 2; return st * 1024 + (ob ^ (((ob >> 9) & 1) << 5)); }
__host__ __device__ __forceinline__ void stage_rc(int b, int& R, int& C) { const int st = b / 1024, sb = b % 1024, swz = sb ^ (((sb >> 9) & 1) << 5); R = (st >> 1) * 16 + swz / 64; C = (st & 1) * 32 + (swz % 64) / 2; }
__host__ __device__ __forceinline__ int perm32(int rho) { const int n = rho >> 4, i = rho & 15; return 8 * (i >> 2) + 4 * n + (i & 3); }
struct Unit { int pm, pn; };
struct Gemm { const bf16_t* A; const bf16_t* Bt; int M, N, K; };
struct StaticOrder {
    int nM, nN, nwg, G, c;
    __host__ __device__ void init(int M, int N, int G_, int c_) { nM = M / BM; nN = N / BM; nwg = nM * nN; G = G_; c = c_; }
    __host__ __device__ bool next(int i, Unit& u) const {
        const long L = (long)i * G + c; if (L >= nwg) return false;
        int wgid = (int)L; { const int q = nwg / NXCD, r = nwg % NXCD, xcd = wgid % NXCD, off = wgid / NXCD; wgid = (xcd < r ? xcd * (q + 1) : r * (q + 1) + (xcd - r) * q) + off; }
        const int nig = WGM * nN, gid = wgid / nig, fm = gid * WGM, gsz = (nM - fm) < WGM ? (nM - fm) : WGM;
        u.pm = fm + ((wgid % nig) % gsz); u.pn = (wgid % nig) / gsz; return true;
    }
    __device__ __forceinline__ void a_ready(const Unit&) const {}
    __device__ __forceinline__ void done(const Unit&) const {}
};
__device__ __forceinline__ unsigned cvt_pk_bf16(float lo, float hi) { unsigned r; asm volatile("v_cvt_pk_bf16_f32 %0, %1, %2" : "=v"(r) : "v"(lo), "v"(hi)); return r; }
__device__ __forceinline__ float sigmoidf_(float x) { return __builtin_amdgcn_rcpf(1.0f + __builtin_amdgcn_exp2f(-1.4426950408889634f * x)); }
__device__ __forceinline__ f32x4 sig4(f32x4 v) { return (f32x4){sigmoidf_(v[0]), sigmoidf_(v[1]), sigmoidf_(v[2]), sigmoidf_(v[3])}; }
__device__ __forceinline__ u32x4 pack8(f32x4 v0, f32x4 v1) { u32x4 w; w.x = cvt_pk_bf16(v0[0], v0[1]); w.y = cvt_pk_bf16(v0[2], v0[3]); w.z = cvt_pk_bf16(v1[0], v1[1]); w.w = cvt_pk_bf16(v1[2], v1[3]); return w; }

__device__ __forceinline__ f32x4 mma_(bf16x8 b, bf16x8 a, f32x4 c) { return __builtin_amdgcn_mfma_f32_16x16x32_bf16(b, a, c, 0, 0, 0); }
__device__ __forceinline__ i32x4 mma_(bf16x8 b, bf16x8 a, i32x4 c) { return __builtin_amdgcn_mfma_i32_16x16x64_i8(__builtin_bit_cast(i32x4, b), __builtin_bit_cast(i32x4, a), c, 0, 0, 0); }
__device__ __forceinline__ f32x4 cvtf(i32x4 v) { return (f32x4){(float)v[0], (float)v[1], (float)v[2], (float)v[3]}; }
struct EpiI8Bf16 {
    static constexpr bool PERM = true, AFTER_DRAIN = false, ROWPERM = false, I8 = true; static constexpr int NS_MIN = 16;
    bf16_t* O; int ldc; const float* su; const float* sw;
    __device__ __forceinline__ void operator()(const i32x4 (&acc)[2][2][4][2], const Unit& u, int wr, int wc, int fr, int fq) const {
        const int row0 = u.pm * BM + wr * 64 + fr, col0 = u.pn * BM + wc * 32 + 8 * fq;
        f32x4 cs_[2][2];
#pragma unroll
        for (int bj = 0; bj < 2; ++bj)
#pragma unroll
            for (int n = 0; n < 2; ++n) cs_[bj][n] = *(const f32x4*)(sw + col0 + bj * HALF + 4 * n);
#pragma unroll
        for (int ai = 0; ai < 2; ++ai)
#pragma unroll
            for (int m = 0; m < 4; ++m) { const int row = row0 + ai * HALF + m * 16; const float rs = su[row]; bf16_t* rowp = O + (size_t)row * ldc + col0;
#pragma unroll
                for (int bj = 0; bj < 2; ++bj) *(u32x4*)(rowp + bj * HALF) = pack8(cvtf(acc[ai][bj][m][0]) * cs_[bj][0] * rs, cvtf(acc[ai][bj][m][1]) * cs_[bj][1] * rs); }
    }
};
struct EpiBf16 {
    static constexpr bool PERM = true, AFTER_DRAIN = false, ROWPERM = false, I8 = false; static constexpr int NS_MIN = 16;
    bf16_t* O; int ldc;
    __device__ __forceinline__ void operator()(const f32x4 (&acc)[2][2][4][2], const Unit& u, int wr, int wc, int fr, int fq) const {
        const int row0 = u.pm * BM + wr * 64 + fr, col0 = u.pn * BM + wc * 32 + 8 * fq;
#pragma unroll
        for (int ai = 0; ai < 2; ++ai)
#pragma unroll
            for (int m = 0; m < 4; ++m) { bf16_t* rowp = O + (size_t)(row0 + ai * HALF + m * 16) * ldc + col0;
#pragma unroll
                for (int bj = 0; bj < 2; ++bj) *(u32x4*)(rowp + bj * HALF) = pack8(acc[ai][bj][m][0], acc[ai][bj][m][1]); }
    }
};
__device__ __forceinline__ unsigned cvt4_fp8_(f32x4 v) { int w = __builtin_amdgcn_cvt_pk_fp8_f32(v[0], v[1], 0, false); return (unsigned)__builtin_amdgcn_cvt_pk_fp8_f32(v[2], v[3], w, true); }
struct EpiInB {
    static constexpr bool PERM = true, AFTER_DRAIN = false, ROWPERM = false, I8 = true; static constexpr int NS_MIN = 16;
    unsigned char* ws; const float *gq, *gk; PG8_LAS float* XS;
    __device__ __forceinline__ void operator()(const i32x4 (&acc)[2][2][4][2], const Unit& u, int wr, int wc, int fr_, int fq_) const {
        bf16_t* const Q = (bf16_t*)(ws + WS_Q); bf16_t* const Kb = (bf16_t*)(ws + WS_K); bf16_t* const Vb = (bf16_t*)(ws + WS_V); bf16_t* const SGA = (bf16_t*)(ws + WS_SGA); bf16_t* const GBS = (bf16_t*)(ws + WS_GBS);
        const float* const rope = (const float*)(ws + WS_ROPE); const float* const su = (const float*)(ws + WS_SU); const float* const sw = (const float*)(ws + WS_SWP);
        int ln = fq_ * 16 + fr_; asm volatile("" : "+v"(ln)); const int fr = ln & 15, fq = ln >> 4;
        const int row0 = u.pm * BM + wr * 64 + fr, cw = wc * 32 + 8 * fq, pn = u.pn;
        f32x4 cs_[2][2];
#pragma unroll
        for (int bj = 0; bj < 2; ++bj)
#pragma unroll
            for (int n = 0; n < 2; ++n) cs_[bj][n] = *(const f32x4*)(sw + pn * 256 + bj * HALF + cw + 4 * n);
        if (pn < 20) {
            const bool isq = pn < 16; signed char* base = isq ? (signed char*)Q + pn * 256 : (signed char*)Kb + (pn - 16) * 256; const int ldc = isq ? DM : KVD; const float* g = isq ? gq : gk;
            const int half = wc >> 1, i0 = 16 * (wc & 1) + 4 * fq, d1 = 64 * half + i0;
            const f32x4 g1 = *(const f32x4*)(g + d1), g2 = *(const f32x4*)(g + d1 + 32);
#pragma unroll
            for (int ai = 0; ai < 2; ++ai)
#pragma unroll
                for (int m = 0; m < 4; ++m) { const float rs = su[row0 + ai * HALF + m * 16];
#pragma unroll
                    for (int bj = 0; bj < 2; ++bj) { const f32x4 a = cvtf(acc[ai][bj][m][0]) * cs_[bj][0] * rs, b = cvtf(acc[ai][bj][m][1]) * cs_[bj][1] * rs;
                        float sq = (a[0] * a[0] + a[1] * a[1]) + (a[2] * a[2] + a[3] * a[3]) + (b[0] * b[0] + b[1] * b[1]) + (b[2] * b[2] + b[3] * b[3]);
                        sq += __shfl_xor(sq, 16); sq += __shfl_xor(sq, 32);
                        if (fq == 0) XS[(ai * HALF + wr * 64 + m * 16 + fr) * 8 + bj * 4 + wc] = sq; } }
            asm volatile("s_waitcnt lgkmcnt(0)" ::: "memory"); __builtin_amdgcn_s_barrier(); asm volatile("" ::: "memory");
#pragma unroll
            for (int ai = 0; ai < 2; ++ai)
#pragma unroll
                for (int m = 0; m < 4; ++m) { const int rit = ai * HALF + wr * 64 + m * 16 + fr, row = u.pm * BM + rit; const float rs = su[row];
                    const int t = row < MP ? (row & (SEQP - 1)) : (row - MP), pos = half ? (t & 63) : (t >> 6);
                    const f32x4 cs = *(const f32x4*)(rope + pos * 32 + i0), sn = *(const f32x4*)(rope + 4096 + pos * 32 + i0);
#pragma unroll
                    for (int bj = 0; bj < 2; ++bj) { const f32x4 ps = *(const PG8_LAS f32x4*)(XS + rit * 8 + bj * 4);
                        const float rstd = rs / sqrtf(((ps[0] + ps[1]) + (ps[2] + ps[3])) * (1.0f / 128.0f) + NORM_EPS);
                        const f32x4 y1 = cvtf(acc[ai][bj][m][0]) * cs_[bj][0] * rstd * g1, y2 = cvtf(acc[ai][bj][m][1]) * cs_[bj][1] * rstd * g2;
                        const f32x4 o1 = y1 * cs - y2 * sn, o2 = y2 * cs + y1 * sn;
                        signed char* op = base + (size_t)row * ldc + bj * HALF + d1;
                        *(unsigned*)op = cvt4_fp8_(o1); *(unsigned*)(op + 32) = cvt4_fp8_(o2); } }
        } else if (pn < 40) {
            const bool sg = pn >= 24; bf16_t* base = sg ? SGA + (pn - 24) * 256 : Vb + (pn - 20) * 256; const int ldc = sg ? DM : KVD;
#pragma unroll
            for (int ai = 0; ai < 2; ++ai)
#pragma unroll
                for (int m = 0; m < 4; ++m) { const int row = row0 + ai * HALF + m * 16; const float rs = su[row]; bf16_t* rowp = base + (size_t)row * ldc + cw;
#pragma unroll
                    for (int bj = 0; bj < 2; ++bj) { f32x4 v0 = cvtf(acc[ai][bj][m][0]) * cs_[bj][0] * rs, v1 = cvtf(acc[ai][bj][m][1]) * cs_[bj][1] * rs; if (sg) { v0 = sig4(v0); v1 = sig4(v1); } *(u32x4*)(rowp + bj * HALF) = pack8(v0, v1); } }
        } else {
            bf16_t* base = GBS + (pn - 40) * 128;
#pragma unroll
            for (int ai = 0; ai < 2; ++ai)
#pragma unroll
                for (int m = 0; m < 4; ++m) { const int row = row0 + ai * HALF + m * 16; const float rs = su[row];
                    const f32x4 v0 = cvtf(acc[ai][0][m][0]) * cs_[0][0] * rs, v1 = cvtf(acc[ai][0][m][1]) * cs_[0][1] * rs;
                    const f32x4 g0 = sig4(cvtf(acc[ai][1][m][0]) * cs_[1][0] * rs), g1 = sig4(cvtf(acc[ai][1][m][1]) * cs_[1][1] * rs);
                    *(u32x4*)(base + (size_t)row * DM + cw) = pack8(v0 * g0, v1 * g1); }
        }
    }
};
struct EpiInA {
    static constexpr bool PERM = true, AFTER_DRAIN = false, ROWPERM = false, I8 = false; static constexpr int NS_MIN = 8;
    bf16_t* P;
    __device__ __forceinline__ void operator()(const f32x4 (&acc)[2][2][4][2], const Unit& u, int wr, int wc, int fr, int fq) const {
        const int row0 = u.pm * BM + wr * 64 + fr, cw = wc * 32 + 8 * fq, pn = u.pn;
        bf16_t* base = P + pn * 128;
#pragma unroll
        for (int ai = 0; ai < 2; ++ai)
#pragma unroll
            for (int m = 0; m < 4; ++m) { bf16_t* rowp = base + (size_t)(row0 + ai * HALF + m * 16) * DM + cw;
                *(u32x4*)rowp = pack8(acc[ai][0][m][0] * acc[ai][1][m][0], acc[ai][0][m][1] * acc[ai][1][m][1]); }
    }
};

__device__ __forceinline__ f32x4 dpp_prev(f32x4 v) { f32x4 r;
#pragma unroll
    for (int e = 0; e < 4; ++e) { const float x = v[e]; r[e] = __int_as_float(__builtin_amdgcn_update_dpp(0, __float_as_int(x), 0x111, 0xf, 0xf, true)); }
    return r; }
__device__ __forceinline__ f32x4 dpp_next(f32x4 v) { f32x4 r;
#pragma unroll
    for (int e = 0; e < 4; ++e) { const float x = v[e]; r[e] = __int_as_float(__builtin_amdgcn_update_dpp(0, __float_as_int(x), 0x101, 0xf, 0xf, true)); }
    return r; }
template <bool I8_> struct EpiUp {
    static constexpr bool PERM = true, AFTER_DRAIN = false, ROWPERM = true, I8 = I8_; static constexpr int NS_MIN = 8;
    typedef typename std::conditional<I8_, i32x4, f32x4>::type acc_t;
    bf16_t* ACT; float* SB; const float* cw; const float* cb; const float* su; const float* sw; int pn0;
    static __device__ __forceinline__ f32x4 asf(f32x4 v) { return v; }
    static __device__ __forceinline__ f32x4 toa(f32x4 v) { return v; }
    __device__ __forceinline__ void operator()(acc_t (&accr)[2][2][4][2], const Unit& u, int wr, int wc, int fr_, int fq_) const {
        int ln = fq_ * 16 + fr_; asm volatile("" : "+v"(ln)); const int fr = ln & 15, fq = ln >> 4;
        const int pn = u.pn + pn0, cw8 = wc * 32 + 8 * fq, f0 = pn * 128 + cw8;
        const int strip = u.pm * 2 + wr; const size_t grow0 = (size_t)u.pm * BM + wr * 128 + fr * 8;
        float* sb = SB + (size_t)strip * 4 * NUP + (size_t)pn * 256 + cw8;
        f32x4 acc[2][2][4][2];
        if constexpr (I8_) {
            const f32x4 rsa = *(const f32x4*)(su + grow0), rsb = *(const f32x4*)(su + grow0 + 4);
#pragma unroll
            for (int j = 0; j < 8; ++j)
#pragma unroll
                for (int bj = 0; bj < 2; ++bj)
#pragma unroll
                    for (int n = 0; n < 2; ++n) { f32x4 t = cvtf(accr[j >> 2][bj][j & 3][n]) * (j < 4 ? rsa[j & 3] : rsb[j & 3]); asm volatile("" : "+v"(t)); acc[j >> 2][bj][j & 3][n] = t; }
        } else {
#pragma unroll
            for (int a = 0; a < 2; ++a)
#pragma unroll
                for (int b = 0; b < 2; ++b)
#pragma unroll
                    for (int m = 0; m < 4; ++m)
#pragma unroll
                        for (int n = 0; n < 2; ++n) acc[a][b][m][n] = accr[a][b][m][n];
        }
        f32x4 wv[2][2][4], csc[2][2];
#pragma unroll
        for (int bj = 0; bj < 2; ++bj)
#pragma unroll
            for (int n = 0; n < 2; ++n) { const int ci = bj * DFF + f0 + 4 * n;
                wv[bj][n][0] = *(const f32x4*)(cw + ci); wv[bj][n][1] = *(const f32x4*)(cw + NUP + ci); wv[bj][n][2] = *(const f32x4*)(cw + 2 * NUP + ci); wv[bj][n][3] = *(const f32x4*)(cb + ci);
                csc[bj][n] = I8_ ? *(const f32x4*)(sw + pn * 256 + bj * HALF + cw8 + 4 * n) : (f32x4){1.f, 1.f, 1.f, 1.f}; }
#pragma unroll
        for (int bj = 0; bj < 2; ++bj)
#pragma unroll
            for (int n = 0; n < 2; ++n) {
                if (fr == 0) *(f32x4*)(sb + bj * 128 + 4 * n) = acc[0][bj][0][n] * csc[bj][n];
                if (fr == 15) *(f32x4*)(sb + NUP + bj * 128 + 4 * n) = acc[1][bj][3][n] * csc[bj][n];
                const f32x4 w0 = wv[bj][n][0] * csc[bj][n], w1 = wv[bj][n][1] * csc[bj][n], w2 = wv[bj][n][2] * csc[bj][n], bb = wv[bj][n][3];
                f32x4 p = dpp_prev(acc[1][bj][3][n]); const f32x4 nx = dpp_next(acc[0][bj][0][n]);
#pragma unroll
                for (int j = 0; j < 8; ++j) { const f32x4 cur = acc[j >> 2][bj][j & 3][n]; const f32x4 nn = j < 7 ? acc[(j + 1) >> 2][bj][(j + 1) & 3][n] : nx;
                    acc[j >> 2][bj][j & 3][n] = w0 * p + (w1 * cur + (w2 * nn + bb)); p = cur; }
                if (fr == 0) *(f32x4*)(sb + 2 * NUP + bj * 128 + 4 * n) = acc[0][bj][0][n];
                if (fr == 15) *(f32x4*)(sb + 3 * NUP + bj * 128 + 4 * n) = acc[1][bj][3][n]; }
#pragma unroll
        for (int j = 0; j < 8; ++j) {
            f32x4 a0 = asf(acc[j >> 2][0][j & 3][0]), a1 = asf(acc[j >> 2][0][j & 3][1]); const f32x4 b0 = asf(acc[j >> 2][1][j & 3][0]), b1 = asf(acc[j >> 2][1][j & 3][1]);
            a0 = a0 * sig4(a0) * b0; a1 = a1 * sig4(a1) * b1;
            const bool skip = (j == 0 && fr == 0) || (j == 7 && fr == 15);
            if (!skip) __builtin_nontemporal_store(pack8(a0, a1), (u32x4*)(ACT + (grow0 + j) * DFF + f0));
            asm volatile("" ::: "memory"); __builtin_amdgcn_sched_barrier(0); }
    }
};

template <class Epi, class Sched, bool ALIGN_EPI = false, bool SP2 = false, bool BAL = false, bool REL = false>
__device__ __forceinline__ void gemm_phase(PG8_LAS unsigned char* lds, const Gemm g, const Sched& S, const Epi& E) {
    int tid_ = threadIdx.x; asm volatile("" : "+v"(tid_));
    const int tid = tid_, wid = __builtin_amdgcn_readfirstlane(tid >> 6), lane = tid & 63, wr = wid >> 2, wc = wid & 3, fr = lane & 15, fq = lane >> 4;
    const int K = g.K, nt = K / BK;
    unsigned voffA, voffB;
    { int R, C; stage_rc(tid * 16, R, C); const int Rb = Epi::PERM ? ((R & ~31) + perm32(R & 31)) : R;
        const int Ra = Epi::ROWPERM ? (128 * (R >> 6) + 8 * (R & 15) + ((R >> 4) & 3)) : R;
        voffA = (unsigned)(Ra * K + C) * 2u; voffB = (unsigned)(Rb * K + C) * 2u; }
    const size_t pstepB = (size_t)64 * K * 2, pstepA = Epi::ROWPERM ? (size_t)128 * K * 2 : pstepB;
    const size_t kstep = (size_t)(BK * 2);
    const size_t hstep = (size_t)HALF * K * 2;
    const size_t hstepA = Epi::ROWPERM ? (size_t)4 * K * 2 : hstep;
    const size_t tstep = 2 * hstep;
    const unsigned ldsw = (unsigned)wid * 1024u;
    const int aoff = lds_byte(wr * 64 + fr, fq * 8), boff = lds_byte(wc * 32 + fr, fq * 8);
#define PG8_SA(b, h) (((b) * 2 + (h)) * HTB)
#define PG8_SB(b, h) ((4 + (b) * 2 + (h)) * HTB)
#define PG8_STAGE(bufoff, gbase, voff) do { _Pragma("unroll") for (int _i = 0; _i < 2; ++_i) \
        __builtin_amdgcn_global_load_lds((const unsigned*)((const char*)(gbase) + (size_t)_i * p##voff + (voff)), (PG8_LAS unsigned*)(lds + (bufoff) + ldsw + _i * 8192), 16, 0, 0); } while (0)
#define pvoffA pstepA
#define pvoffB pstepB
#define PG8_LDA(dst, b, h) do { _Pragma("unroll") for (int m = 0; m < 4; ++m) _Pragma("unroll") for (int k = 0; k < 2; ++k) dst[m][k] = *(const PG8_LAS bf16x8*)(lds + PG8_SA(b, h) + aoff + m * 2048 + k * 1024); } while (0)
#define PG8_LDB(dst, b, h) do { _Pragma("unroll") for (int n = 0; n < 2; ++n) _Pragma("unroll") for (int k = 0; k < 2; ++k) dst[n][k] = *(const PG8_LAS bf16x8*)(lds + PG8_SB(b, h) + boff + n * 2048 + k * 1024); } while (0)
#define PG8_MMA(ai, bj, At, Bt) do { __builtin_amdgcn_s_setprio(1); _Pragma("unroll") for (int m = 0; m < 4; ++m) _Pragma("unroll") for (int n = 0; n < 2; ++n) _Pragma("unroll") for (int k = 0; k < 2; ++k) \
        acc[ai][bj][m][n] = mma_(Bt[n][k], At[m][k], acc[ai][bj][m][n]); __builtin_amdgcn_s_setprio(0); } while (0)
#define PG8_WAIT_V(n) asm volatile("s_waitcnt vmcnt(" #n ")" ::: "memory")
#define PG8_WAIT_VN(N) asm volatile("s_waitcnt vmcnt(%0)" :: "i"(N) : "memory")
#define PG8_WAIT_L(n) asm volatile("s_waitcnt lgkmcnt(" #n ")" ::: "memory")
#define PG8_BAR __builtin_amdgcn_s_barrier()
#define PG8_SCHED __builtin_amdgcn_sched_barrier(0)
    Unit cur, nxt; int ui = 0;
    if (!S.next(0, cur)) return;
    typedef typename std::conditional<Epi::I8, i32x4, f32x4>::type acc_t;
    acc_t acc[2][2][4][2];
#pragma unroll
    for (int a = 0; a < 2; ++a)
#pragma unroll
        for (int b = 0; b < 2; ++b)
#pragma unroll
            for (int m = 0; m < 4; ++m)
#pragma unroll
                for (int n = 0; n < 2; ++n) acc[a][b][m][n] = (acc_t){0, 0, 0, 0};
    bf16x8 At[4][2], B0[2][2], B1[2][2];
    const char* cA = (const char*)g.A + (size_t)cur.pm * tstep; const char* cB = (const char*)g.Bt + (size_t)cur.pn * tstep;
    S.a_ready(cur);
    if constexpr (SP2 && BAL && REL) {
        PG8_STAGE(PG8_SB(0, 0), cB, voffB); PG8_STAGE(PG8_SB(0, 1), cB + hstep, voffB); PG8_STAGE(PG8_SA(0, 0), cA, voffA); PG8_STAGE(PG8_SA(0, 1), cA + hstepA, voffA);
        PG8_STAGE(PG8_SB(1, 0), cB + kstep, voffB); PG8_STAGE(PG8_SB(1, 1), cB + hstep + kstep, voffB); PG8_STAGE(PG8_SA(1, 0), cA + kstep, voffA); PG8_STAGE(PG8_SA(1, 1), cA + kstep + hstepA, voffA);
        if (wr == 1) PG8_BAR;
        PG8_WAIT_V(0); PG8_BAR;
        PG8_BAR;
    } else if constexpr (SP2 && BAL) {
        PG8_STAGE(PG8_SB(0, 0), cB, voffB); PG8_STAGE(PG8_SB(0, 1), cB + hstep, voffB); PG8_STAGE(PG8_SA(0, 0), cA, voffA); PG8_STAGE(PG8_SA(0, 1), cA + hstepA, voffA);
        if (wr == 1) PG8_BAR;
        PG8_WAIT_V(2); PG8_BAR;
        PG8_STAGE(PG8_SB(1, 0), cB + kstep, voffB); PG8_STAGE(PG8_SB(1, 1), cB + hstep + kstep, voffB);
        PG8_BAR;
    } else if constexpr (SP2) {
        PG8_STAGE(PG8_SB(0, 0), cB, voffB); PG8_STAGE(PG8_SB(0, 1), cB + hstep, voffB); PG8_STAGE(PG8_SA(0, 0), cA, voffA); PG8_STAGE(PG8_SA(0, 1), cA + hstepA, voffA);
        if (wr == 1) PG8_BAR;
        PG8_WAIT_V(2); PG8_BAR;
        PG8_STAGE(PG8_SB(1, 0), cB + kstep, voffB); PG8_STAGE(PG8_SA(1, 0), cA + kstep, voffA); PG8_STAGE(PG8_SB(1, 1), cB + hstep + kstep, voffB);
        PG8_WAIT_V(6); PG8_BAR;
    } else {
        PG8_STAGE(PG8_SB(0, 0), cB, voffB); PG8_STAGE(PG8_SA(0, 0), cA, voffA); PG8_STAGE(PG8_SB(0, 1), cB + hstep, voffB); PG8_STAGE(PG8_SA(0, 1), cA + hstepA, voffA);
        if (wr == 1) PG8_BAR;
        PG8_WAIT_V(4); PG8_BAR;
        PG8_STAGE(PG8_SB(1, 0), cB + kstep, voffB); PG8_STAGE(PG8_SA(1, 0), cA + kstep, voffA); PG8_STAGE(PG8_SB(1, 1), cB + hstep + kstep, voffB);
        PG8_WAIT_V(6); PG8_BAR;
    }
    for (;;) {
        const bool has_next = S.next(ui + 1, nxt);
        const char* nA = has_next ? (const char*)g.A + (size_t)nxt.pm * tstep : cA; const char* nB = has_next ? (const char*)g.Bt + (size_t)nxt.pn * tstep : cB;
        for (int t = 0; t < nt; t += 2) {
            const bool last = (t == nt - 2);
            const char* a1 = cA + (size_t)(t + 1) * kstep;
            const char* a2 = last ? nA : cA + (size_t)(t + 2) * kstep; const char* b2 = last ? nB : cB + (size_t)(t + 2) * kstep;
            const char* a3 = a2 + kstep; const char* b3 = b2 + kstep;
            if (last && has_next) S.a_ready(nxt);
            if constexpr (SP2 && BAL) {
            constexpr int NS = Epi::NS_MIN; const bool first = REL && (t == 0);
            PG8_LDB(B0, 0, 0); PG8_LDB(B1, 0, 1); PG8_SCHED; PG8_LDA(At, 0, 0); if (!REL || !first) { PG8_STAGE(PG8_SA(1, 0), a1, voffA); PG8_STAGE(PG8_SA(1, 1), a1 + hstepA, voffA); }
            if (REL && first) PG8_WAIT_VN(8 + NS); else PG8_WAIT_V(8);
            PG8_WAIT_L(0); PG8_BAR; PG8_MMA(0, 0, At, B0); PG8_MMA(0, 1, At, B1); PG8_BAR; PG8_SCHED;
            PG8_LDA(At, 0, 1); PG8_STAGE(PG8_SB(0, 0), b2, voffB); PG8_STAGE(PG8_SB(0, 1), b2 + hstep, voffB);
            if (REL && first) PG8_WAIT_VN(6 + NS); else PG8_WAIT_V(6);
            PG8_WAIT_L(0); PG8_BAR; PG8_MMA(1, 0, At, B0); PG8_MMA(1, 1, At, B1); PG8_BAR; PG8_SCHED;
            PG8_LDB(B0, 1, 0); PG8_LDB(B1, 1, 1); PG8_SCHED; PG8_LDA(At, 1, 0); PG8_STAGE(PG8_SA(0, 0), a2, voffA); PG8_STAGE(PG8_SA(0, 1), a2 + hstepA, voffA);
            if (REL && first) PG8_WAIT_VN(8 + NS); else PG8_WAIT_V(8);
            PG8_WAIT_L(0); PG8_BAR; PG8_MMA(0, 0, At, B0); PG8_MMA(0, 1, At, B1); PG8_BAR; PG8_SCHED;
            PG8_LDA(At, 1, 1); PG8_STAGE(PG8_SB(1, 0), b3, voffB); PG8_STAGE(PG8_SB(1, 1), b3 + hstep, voffB);
            PG8_WAIT_V(6); PG8_WAIT_L(0); PG8_BAR; PG8_MMA(1, 0, At, B0); PG8_MMA(1, 1, At, B1); PG8_BAR; PG8_SCHED;
            } else if constexpr (SP2) {
            PG8_LDB(B0, 0, 0); PG8_LDB(B1, 0, 1); PG8_SCHED; PG8_LDA(At, 0, 0); PG8_STAGE(PG8_SA(1, 1), a1 + hstepA, voffA);
            PG8_WAIT_V(8); PG8_WAIT_L(0); PG8_BAR; PG8_MMA(0, 0, At, B0); PG8_MMA(0, 1, At, B1); PG8_BAR; PG8_SCHED;
            PG8_LDA(At, 0, 1); PG8_STAGE(PG8_SB(0, 0), b2, voffB); PG8_STAGE(PG8_SB(0, 1), b2 + hstep, voffB); PG8_STAGE(PG8_SA(0, 0), a2, voffA);
            PG8_WAIT_V(8); PG8_WAIT_L(0); PG8_BAR; PG8_MMA(1, 0, At, B0); PG8_MMA(1, 1, At, B1); PG8_BAR; PG8_SCHED;
            PG8_LDB(B0, 1, 0); PG8_LDB(B1, 1, 1); PG8_SCHED; PG8_LDA(At, 1, 0); PG8_STAGE(PG8_SA(0, 1), a2 + hstepA, voffA);
            PG8_WAIT_V(8); PG8_WAIT_L(0); PG8_BAR; PG8_MMA(0, 0, At, B0); PG8_MMA(0, 1, At, B1); PG8_BAR; PG8_SCHED;
            PG8_LDA(At, 1, 1); PG8_STAGE(PG8_SB(1, 0), b3, voffB); PG8_STAGE(PG8_SB(1, 1), b3 + hstep, voffB); PG8_STAGE(PG8_SA(1, 0), a3, voffA);
            PG8_WAIT_V(8); PG8_WAIT_L(0); PG8_BAR; PG8_MMA(1, 0, At, B0); PG8_MMA(1, 1, At, B1); PG8_BAR; PG8_SCHED;
            } else {
            PG8_LDB(B0, 0, 0); PG8_SCHED; PG8_LDA(At, 0, 0); PG8_STAGE(PG8_SA(1, 1), a1 + hstepA, voffA);
            PG8_WAIT_L(8); PG8_BAR; PG8_WAIT_L(0); PG8_MMA(0, 0, At, B0); PG8_BAR; PG8_SCHED;
            PG8_LDB(B1, 0, 1); PG8_STAGE(PG8_SB(0, 0), b2, voffB);
            PG8_BAR; PG8_WAIT_L(0); PG8_MMA(0, 1, At, B1); PG8_BAR;
            PG8_LDA(At, 0, 1); PG8_STAGE(PG8_SA(0, 0), a2, voffA);
            PG8_BAR; PG8_WAIT_L(0); PG8_MMA(1, 0, At, B0); PG8_BAR; PG8_SCHED;
            PG8_STAGE(PG8_SB(0, 1), b2 + hstep, voffB);
            PG8_WAIT_V(6); PG8_BAR; PG8_MMA(1, 1, At, B1); PG8_BAR;
            PG8_LDB(B0, 1, 0); PG8_SCHED; PG8_LDA(At, 1, 0); PG8_STAGE(PG8_SA(0, 1), a2 + hstepA, voffA);
            PG8_WAIT_L(8); PG8_BAR; PG8_WAIT_L(0); PG8_MMA(0, 0, At, B0); PG8_BAR; PG8_SCHED;
            PG8_LDB(B1, 1, 1); PG8_STAGE(PG8_SB(1, 0), b3, voffB);
            PG8_BAR; PG8_WAIT_L(0); PG8_MMA(0, 1, At, B1); PG8_BAR;
            PG8_LDA(At, 1, 1); PG8_STAGE(PG8_SA(1, 0), a3, voffA);
            PG8_BAR; PG8_WAIT_L(0); PG8_MMA(1, 0, At, B0); PG8_BAR; PG8_SCHED;
            PG8_STAGE(PG8_SB(1, 1), b3 + hstep, voffB);
            PG8_WAIT_V(6); PG8_BAR; PG8_MMA(1, 1, At, B1); PG8_BAR;
            }
        }
        if constexpr (SP2 && BAL && REL) { if (has_next) { PG8_STAGE(PG8_SA(1, 0), nA + kstep, voffA); PG8_STAGE(PG8_SA(1, 1), nA + kstep + hstepA, voffA); } }
        if constexpr (ALIGN_EPI) { if (wr == 0) PG8_BAR; }
        if constexpr (!Epi::AFTER_DRAIN) { E(acc, cur, wr, wc, fr, fq); S.done(cur); }
        if (!has_next) break;
#pragma unroll
        for (int a = 0; a < 2; ++a)
#pragma unroll
            for (int b = 0; b < 2; ++b)
#pragma unroll
                for (int m = 0; m < 4; ++m)
#pragma unroll
                    for (int n = 0; n < 2; ++n) acc[a][b][m][n] = (acc_t){0, 0, 0, 0};
        cur = nxt; cA = nA; cB = nB; ++ui;
        if constexpr (ALIGN_EPI) { if (wr == 1) PG8_BAR; }
    }
    PG8_WAIT_V(0);
    if constexpr (!ALIGN_EPI) { if (wr == 0) PG8_BAR; }
    PG8_BAR;
#undef PG8_SA
#undef PG8_SB
#undef PG8_STAGE
#undef pvoffA
#undef pvoffB
#undef PG8_LDA
#undef PG8_LDB
#undef PG8_MMA
#undef PG8_WAIT_V
#undef PG8_WAIT_VN
#undef PG8_WAIT_L
#undef PG8_BAR
#undef PG8_SCHED
}
}
#define PG8_SP2 true
#define PG8_ALIGN true
#define PG8_BAL true

namespace att {
constexpr int D = 128, NW = 8, QBLK = 32, KVBLK = 64;
constexpr float SCALE = 0.088388347648318440f;
constexpr float THR = 5.f;
constexpr int LDQ = DM, LDK = KVD;
constexpr size_t SHM_V = KVBLK * D * 2, SHM_K = KVBLK * D * 2, SHM_K8 = KVBLK * D;
#define KSWZ(row, colB) ((row) * 256 + ((colB) ^ (((row) & 7) << 4)))
#define SBAR() __builtin_amdgcn_sched_barrier(0)
__device__ __forceinline__ int crow(int r, int hi) { return (r & 3) + 8 * (r >> 2) + 4 * hi; }
__device__ __forceinline__ unsigned cvtpk(float lo, float hi) { unsigned r; asm volatile("v_cvt_pk_bf16_f32 %0, %1, %2" : "=v"(r) : "v"(lo), "v"(hi)); return r; }
__device__ __forceinline__ void partialSM(f32x16& p0, f32x16& p1, float& m_reg, float& mn, float& alpha) {
  constexpr float C = SCALE * 1.4426950408889634f, THRQ = THR / SCALE;
  float pmax = p0[0];
#pragma unroll
  for (int r = 1; r < 16; ++r) pmax = fmaxf(pmax, p0[r]);
#pragma unroll
  for (int r = 0; r < 16; ++r) pmax = fmaxf(pmax, p1[r]);
  { auto rr = __builtin_amdgcn_permlane32_swap(__float_as_uint(pmax), __float_as_uint(pmax), false, false);
    pmax = fmaxf(__uint_as_float(rr[0]), __uint_as_float(rr[1])); }
  if (__builtin_expect(__all(pmax - m_reg <= THRQ), 1)) { mn = m_reg; alpha = 1.f; }
  else { mn = fmaxf(m_reg, pmax); alpha = __builtin_amdgcn_exp2f((m_reg - mn) * C); m_reg = mn; }
  float mnC = -mn * C;
#pragma unroll
  for (int r = 0; r < 16; ++r) p0[r] = fmaf(p0[r], C, mnC);
#pragma unroll
  for (int r = 0; r < 16; ++r) p1[r] = fmaf(p1[r], C, mnC);
#pragma unroll
  for (int r = 0; r < 16; ++r) p0[r] = __builtin_amdgcn_exp2f(p0[r]);
}
typedef int i32x8 __attribute__((ext_vector_type(8)));
__device__ __forceinline__ int cvt4_fp8(float a, float b, float c, float d) { int w = __builtin_amdgcn_cvt_pk_fp8_f32(a, b, 0, false); return __builtin_amdgcn_cvt_pk_fp8_f32(c, d, w, true); }
__device__ __forceinline__ void finishSM(f32x16& p0, f32x16& p1, i32x8& pf) {
#pragma unroll
  for (int r = 0; r < 16; ++r) p1[r] = __builtin_amdgcn_exp2f(p1[r]);
#pragma unroll
  for (int i = 0; i < 4; ++i) { pf[i] = cvt4_fp8(p0[4 * i], p0[4 * i + 1], p0[4 * i + 2], p0[4 * i + 3]); pf[4 + i] = cvt4_fp8(p1[4 * i], p1[4 * i + 1], p1[4 * i + 2], p1[4 * i + 3]); }
}
#define KSWZ8(row, colB) ((row) * 128 + ((colB) ^ ((((row) >> 1) & 7) << 4)))
__device__ __forceinline__ void qkt(f32x16& p0, f32x16& p1, const char* Ks, const i32x8* qr, int r32, int hi) {
  p0 = f32x16{}; p1 = f32x16{};
#pragma unroll
  for (int d0 = 0; d0 < 2; ++d0) { const int cb = d0 * 64 + hi * 32;
    const i32x4 a0 = *reinterpret_cast<const i32x4*>(Ks + KSWZ8(r32, cb)), a1 = *reinterpret_cast<const i32x4*>(Ks + KSWZ8(r32, cb + 16));
    const i32x4 b0 = *reinterpret_cast<const i32x4*>(Ks + KSWZ8(32 + r32, cb)), b1 = *reinterpret_cast<const i32x4*>(Ks + KSWZ8(32 + r32, cb + 16));
    const i32x8 k0 = {a0[0], a0[1], a0[2], a0[3], a1[0], a1[1], a1[2], a1[3]}, k1 = {b0[0], b0[1], b0[2], b0[3], b1[0], b1[1], b1[2], b1[3]};
    p0 = __builtin_amdgcn_mfma_scale_f32_32x32x64_f8f6f4(k0, qr[d0], p0, 0, 0, 0, 0x7f7f7f7f, 0, 0x7f7f7f7f);
    p1 = __builtin_amdgcn_mfma_scale_f32_32x32x64_f8f6f4(k1, qr[d0], p1, 0, 0, 0, 0x7f7f7f7f, 0, 0x7f7f7f7f); }
}
__device__ __forceinline__ void pv_fp8(f32x16* o, f32x16& ol, const char* Vt, int voA, int voB, const i32x8 pf) {
  const i32x8 ones = {0x38383838, 0x38383838, 0x38383838, 0x38383838, 0x38383838, 0x38383838, 0x38383838, 0x38383838};
  ol = __builtin_amdgcn_mfma_scale_f32_32x32x64_f8f6f4(pf, ones, ol, 0, 0, 0, 0x7f7f7f7f, 0, 0x7f7f7f7f);
#pragma unroll
  for (int d0 = 0; d0 < 4; ++d0) {
    const i32x4 a = *reinterpret_cast<const i32x4*>(Vt + d0 * 2048 + voA), b = *reinterpret_cast<const i32x4*>(Vt + d0 * 2048 + voB);
    const i32x8 vf = {a[0], a[1], a[2], a[3], b[0], b[1], b[2], b[3]};
    o[d0] = __builtin_amdgcn_mfma_scale_f32_32x32x64_f8f6f4(pf, vf, o[d0], 0, 0, 0, 0x7f7f7f7f, 0, 0x7f7f7f7f);
  }
}
__device__ __forceinline__ float bflo(unsigned w) { return __uint_as_float(w << 16); }
__device__ __forceinline__ float bfhi(unsigned w) { return __uint_as_float(w & 0xffff0000u); }
struct Merge { const bf16* SGA; const bf16* GBS; const bf16* P; const float* cw; const float* cb; };
__device__ __forceinline__ void attn_unit(const signed char* __restrict__ Qb, bf16* __restrict__ Ob, const signed char* __restrict__ Kh, const unsigned char* __restrict__ Vh, int seq, int t0, size_t grow0, int h,
                                          const Merge& mg, char* lds, char* scr, int tid) {
  const int wid = tid >> 6, lane = tid & 63, r32 = lane & 31, hi = lane >> 5;
  char* V_lds = lds; char* K_lds = lds + 2 * SHM_K8;
  float* al_l = (float*)scr + wid * 64 + 32;
  float m_reg = -1e30f; f32x16 o[4] = {}, ol = {}; i32x8 qr[2];
  const signed char* Qw = Qb + (long)(wid * QBLK + r32) * LDQ + hi * 32;
#pragma unroll
  for (int d0 = 0; d0 < 2; ++d0) { const i32x4 a = *reinterpret_cast<const i32x4*>(Qw + d0 * 64), b = *reinterpret_cast<const i32x4*>(Qw + d0 * 64 + 16); qr[d0] = (i32x8){a[0], a[1], a[2], a[3], b[0], b[1], b[2], b[3]}; }
  const int vd = tid >> 2, vst = vd * 64 + (((tid & 3) ^ ((vd >> 2) & 3)) << 4);
  const int vsw = (r32 >> 2) & 3, voA = r32 * 64 + (((2 * hi) ^ vsw) << 4), voB = r32 * 64 + (((2 * hi + 1) ^ vsw) << 4);
  struct { i32x4 vs, ks; } sr_[2];
  const int kr = tid >> 3, kc = (tid & 7) * 16; const unsigned ko8 = (unsigned)(kr * LDK + kc);
  const unsigned vo8 = (unsigned)tid * 16u;
#define SLOAD(i, k0) do { const unsigned char* vt_ = Vh + (size_t)(k0) * 128; const signed char* kt_ = Kh + (size_t)(k0) * LDK; \
    sr_[i].vs = *reinterpret_cast<const i32x4*>(vt_ + vo8); sr_[i].ks = *reinterpret_cast<const i32x4*>(kt_ + ko8); } while (0)
#define SWRITE(b, i) do { *(i32x4*)(V_lds + (b) * SHM_K8 + vst) = sr_[i].vs; *(i32x4*)(K_lds + (b) * SHM_K8 + KSWZ8(kr, kc)) = sr_[i].ks; } while (0)
#define SWAIT() asm volatile("s_waitcnt vmcnt(2)" ::: "memory")
#define RESC(a) do { if (__any((a) < 1.f)) { if (hi == 0) al_l[r32] = (a); asm volatile("s_waitcnt lgkmcnt(0)" ::: "memory"); \
    _Pragma("unroll") for (int r = 0; r < 16; ++r) { const float a_ = al_l[crow(r, hi)]; ol[r] *= a_; _Pragma("unroll") for (int d = 0; d < 4; ++d) o[d][r] *= a_; } } } while (0)
  f32x16 pA0, pA1, pB0, pB1; float mnA, mnB, alA, alB; i32x8 pf; const int NT = seq / KVBLK;
  constexpr int SE = 0, SO = 1;
  SLOAD(SE, 0); asm volatile("s_waitcnt vmcnt(0)" ::: "memory"); SWRITE(0, SE); __syncthreads();
  qkt(pA0, pA1, K_lds, qr, r32, hi); partialSM(pA0, pA1, m_reg, mnA, alA);
  SLOAD(SO, KVBLK); if (2 < NT) SLOAD(SE, 2 * KVBLK);
  SWAIT(); SWRITE(1, SO); __syncthreads();
  for (int j = 1; j + 1 < NT; j += 2) {
    SBAR(); qkt(pB0, pB1, K_lds + SHM_K8, qr, r32, hi);
    finishSM(pA0, pA1, pf); SBAR();
    SLOAD(SO, (j + 2) * KVBLK); SBAR();
    pv_fp8(o, ol, V_lds, voA, voB, pf); partialSM(pB0, pB1, m_reg, mnB, alB);
    __syncthreads(); SWAIT(); SWRITE(0, SE);
    RESC(alB); __syncthreads();
    SBAR(); qkt(pA0, pA1, K_lds, qr, r32, hi);
    finishSM(pB0, pB1, pf); SBAR();
    if (j + 3 < NT) SLOAD(SE, (j + 3) * KVBLK); SBAR();
    pv_fp8(o, ol, V_lds + SHM_K8, voA, voB, pf); partialSM(pA0, pA1, m_reg, mnA, alA);
    __syncthreads(); SWAIT(); SWRITE(1, SO);
    RESC(alA); __syncthreads();
  }
  SBAR(); qkt(pB0, pB1, K_lds + SHM_K8, qr, r32, hi);
  finishSM(pA0, pA1, pf); SBAR();
  pv_fp8(o, ol, V_lds, voA, voB, pf); partialSM(pB0, pB1, m_reg, mnB, alB);
  __syncthreads(); RESC(alB);
  finishSM(pB0, pB1, pf); SBAR();
  pv_fp8(o, ol, V_lds + SHM_K8, voA, voB, pf);
  float rli[16];
#pragma unroll
  for (int r = 0; r < 16; ++r) rli[r] = __builtin_amdgcn_rcpf(ol[r]);
  asm volatile("s_waitcnt vmcnt(0) lgkmcnt(0)" ::: "memory");
  __syncthreads();
  float* OS = (float*)(lds + wid * 16384);
#pragma unroll
  for (int r = 0; r < 16; ++r) { const int orow = crow(r, hi);
#pragma unroll
    for (int d0 = 0; d0 < 4; ++d0) OS[orow * 128 + d0 * 32 + r32] = o[d0][r] * rli[r]; }
  asm volatile("s_waitcnt lgkmcnt(0)" ::: "memory");
  int tid2 = tid; asm volatile("" : "+v"(tid2));
  const int lane2 = tid2 & 63, cg = lane2 & 15, rl = lane2 >> 4, col = h * 128 + cg * 8, widu = __builtin_amdgcn_readfirstlane(tid2 >> 6);
  float w0[8], w1[8], w2[8], cbv[8];
#pragma unroll
  for (int e = 0; e < 8; ++e) { w0[e] = mg.cw[col + e]; w1[e] = mg.cw[DM + col + e]; w2[e] = mg.cw[2 * DM + col + e]; cbv[e] = mg.cb[col + e]; }
  const size_t wbase = (grow0 + (size_t)(widu * 32)) * DM + (size_t)(h * 128);
  const unsigned loff = (unsigned)(rl * DM + cg * 8);
  const float* OSr = OS + rl * 128 + cg * 8;
  struct MgLd { u32x4 sg, gb, pc, pm, pp; };
#define MG_LOAD(PS, D) do { const int ps_ = (PS); const int t_ = t0 + widu * 32 + ps_ * 4 + rl; const size_t ub_ = wbase + (size_t)(ps_ * 4) * DM; \
    const bf16* pcp_ = mg.P + ub_; (D).sg = *(const u32x4*)(mg.SGA + ub_ + loff); (D).gb = *(const u32x4*)(mg.GBS + ub_ + loff); (D).pc = *(const u32x4*)(pcp_ + loff); \
    (D).pm = (u32x4){0u, 0u, 0u, 0u}; (D).pp = (u32x4){0u, 0u, 0u, 0u}; if (t_ > 0) (D).pm = *(const u32x4*)(pcp_ - DM + loff); if (t_ < seq - 1) (D).pp = *(const u32x4*)(pcp_ + DM + loff); } while (0)
#define MG_COMP(PS, D) do { const int ps_ = (PS); const f32x4 a0 = *(const f32x4*)(OSr + ps_ * 512), a1 = *(const f32x4*)(OSr + ps_ * 512 + 4); \
    const float av[8] = {a0[0], a0[1], a0[2], a0[3], a1[0], a1[1], a1[2], a1[3]}; float ov[8]; \
    _Pragma("unroll") for (int e = 0; e < 8; ++e) { const unsigned wsg = (D).sg[e >> 1], wgb = (D).gb[e >> 1], wpc = (D).pc[e >> 1], wpm = (D).pm[e >> 1], wpp = (D).pp[e >> 1]; \
      const float fsg = (e & 1) ? bfhi(wsg) : bflo(wsg), fgb = (e & 1) ? bfhi(wgb) : bflo(wgb), fpc = (e & 1) ? bfhi(wpc) : bflo(wpc), fpm = (e & 1) ? bfhi(wpm) : bflo(wpm), fpp = (e & 1) ? bfhi(wpp) : bflo(wpp); \
      const float cv = fmaf(w0[e], fpm, fmaf(w1[e], fpc, fmaf(w2[e], fpp, cbv[e]))); ov[e] = fmaf(fsg, av[e], fgb * cv); } \
    u32x4 w_; w_.x = cvtpk(ov[0], ov[1]); w_.y = cvtpk(ov[2], ov[3]); w_.z = cvtpk(ov[4], ov[5]); w_.w = cvtpk(ov[6], ov[7]); \
    *(u32x4*)(Ob + (size_t)(widu * 32 + ps_ * 4) * LDQ + loff) = w_; } while (0)
  MgLd LA, LB;
  MG_LOAD(0, LA);
#pragma unroll 1
  for (int ps = 0; ps < 8; ps += 2) { MG_LOAD(ps + 1, LB); MG_COMP(ps, LA); if (ps + 2 < 8) MG_LOAD(ps + 2, LA); MG_COMP(ps + 1, LB); }
#undef MG_LOAD
#undef MG_COMP
  asm volatile("s_waitcnt lgkmcnt(0)" ::: "memory");
  __syncthreads();
#undef SLOAD
#undef SWRITE
#undef SWAIT
#undef RESC
}
}

typedef GAS unsigned gu32;
#define RLX_AGENT __ATOMIC_RELAXED, __HIP_MEMORY_SCOPE_AGENT
#define LDS_WAIT() asm volatile("s_waitcnt lgkmcnt(0)" ::: "memory")
#define VM_WAIT() asm volatile("s_waitcnt vmcnt(0)" ::: "memory")
__device__ __forceinline__ unsigned f2bf(float f) { unsigned u = __builtin_bit_cast(unsigned, f); return (u + 0x7fffu + ((u >> 16) & 1u)) >> 16; }
__device__ __forceinline__ unsigned pk2(float lo, float hi) { unsigned r; asm volatile("v_cvt_pk_bf16_f32 %0, %1, %2" : "=v"(r) : "v"(lo), "v"(hi)); return r; }
__device__ __forceinline__ float bflo(unsigned w) { return __uint_as_float(w << 16); }
__device__ __forceinline__ float bfhi(unsigned w) { return __uint_as_float(w & 0xffff0000u); }

#define XB_TMO      128
#define XB_XCNT(j)  (256  + 64 * (j))
#define XB_XSUB(j)  (1280 + 64 * (j))
#define XB_XGEN(j)  (2304 + 64 * (j))
#define XB_TOP      3328
#define XB_TOPGEN   3392
#define XCD_BAR_WORDS 3456
#define XB_SPIN_CAP (1u << 18)
__device__ __forceinline__ unsigned xb_ld(unsigned* p)              { return __hip_atomic_load(p, __ATOMIC_RELAXED, __HIP_MEMORY_SCOPE_AGENT); }
__device__ __forceinline__ unsigned xb_add(unsigned* p, unsigned v) { return __hip_atomic_fetch_add(p, v, __ATOMIC_RELAXED, __HIP_MEMORY_SCOPE_AGENT); }
__device__ __forceinline__ unsigned xb_xcc_id() { return (unsigned)__builtin_amdgcn_s_getreg((3 << 11) | 20) & 0xFu; }
#define XB_SPIN(cond, bar) do { unsigned _sp = 0; while (cond) { __builtin_amdgcn_s_sleep(1); \
    if ((++_sp & 255u) == 0u) { if (xb_ld(&(bar)[XB_TMO])) break; if (_sp > XB_SPIN_CAP) { atomicAdd(&(bar)[XB_TMO], 1u); break; } } } } while (0)
struct XcdBarrier { unsigned* bar; unsigned x; volatile LAS unsigned* st; };
__device__ __forceinline__ XcdBarrier xcd_barrier_post(unsigned* bar, volatile LAS unsigned* st) {
    XcdBarrier b; b.bar = bar; b.x = xb_xcc_id(); b.st = st;
    if (threadIdx.x == 0) (void)xb_add(&bar[XB_XCNT(b.x)], 1u);
    return b;
}
__device__ __forceinline__ void xcd_barrier_complete(unsigned* bar, unsigned x, unsigned& nloc, unsigned& nx) {
    const unsigned G = gridDim.x * gridDim.y * gridDim.z;
    unsigned sum, cnt, mine, sp = 0u;
    for (;;) {
        sum = 0u; cnt = 0u; mine = 0u;
#pragma unroll
        for (unsigned j = 0; j < 16; ++j) { const unsigned c = xb_ld(&bar[XB_XCNT(j)]); sum += c; cnt += (c > 0u) ? 1u : 0u; mine = (j == x) ? c : mine; }
        if (sum == G) break;
        __builtin_amdgcn_s_sleep(1);
        if ((++sp & 255u) == 0u) { if (xb_ld(&bar[XB_TMO])) break; if (sp > XB_SPIN_CAP) { atomicAdd(&bar[XB_TMO], 1u); break; } }
    }
    nloc = mine > 0u ? mine : 1u; nx = cnt > 0u ? cnt : 1u;
}
__device__ __forceinline__ void xcd_barrier(const XcdBarrier& b) {
    asm volatile("s_waitcnt vmcnt(0)" ::: "memory");
    __syncthreads();
    if (threadIdx.x == 0) {
        unsigned* bar = b.bar;
        __builtin_amdgcn_s_waitcnt(0);
        unsigned nloc = b.st[0], nx = b.st[1];
        if (nloc == 0u) { xcd_barrier_complete(bar, b.x, nloc, nx); b.st[0] = nloc; b.st[1] = nx; }
        const unsigned old = xb_add(&bar[XB_XSUB(b.x)], 1u);
        const unsigned gen = old / nloc;
        if (old + 1u == (gen + 1u) * nloc) {
            __builtin_amdgcn_fence(__ATOMIC_RELEASE, "agent");
            asm volatile("s_waitcnt vmcnt(0)" ::: "memory");
            const unsigned og = xb_add(&bar[XB_TOP], 1u);
            const unsigned tg = og / nx;
            if (og + 1u == (tg + 1u) * nx) xb_add(&bar[XB_TOPGEN], 1u);
            else XB_SPIN(xb_ld(&bar[XB_TOPGEN]) == tg, bar);
            __builtin_amdgcn_fence(__ATOMIC_ACQUIRE, "agent");
            xb_add(&bar[XB_XGEN(b.x)], 1u);
            asm volatile("s_waitcnt vmcnt(0)" ::: "memory");
        } else {
            XB_SPIN(xb_ld(&bar[XB_XGEN(b.x)]) == gen, bar);
            __builtin_amdgcn_fence(__ATOMIC_ACQUIRE, "agent");
            asm volatile("s_waitcnt vmcnt(0)" ::: "memory");
        }
    }
    __syncthreads();
}

struct Args {
    const float *xp, *xs, *cp, *cs, *w_ada, *b_ada, *g_mix_pre, *w_in, *g_q, *g_k, *conv_w, *conv_b, *w_o, *g_mix_post, *g_ffn_pre, *w_up, *ffn_conv_w, *ffn_conv_b, *w_down, *g_ffn_post;
    float* out; unsigned char* ws; int ph_lo, ph_hi;
};
struct Frame { LAS unsigned char* lds; int tid, lane, wave, vcu, G; };
typedef const Args __attribute__((address_space(4)))* ArgsP;
__device__ __forceinline__ ArgsP kargs() { ArgsP p = (ArgsP)__builtin_amdgcn_kernarg_segment_ptr(); asm volatile("" : "+s"(p)); return p; }
__device__ __forceinline__ Frame make_frame(LAS unsigned char* lds) { Frame F; F.lds = lds; int t = threadIdx.x; asm volatile("" : "+v"(t)); F.tid = t; F.lane = t & 63; F.wave = __builtin_amdgcn_readfirstlane(t >> 6);
    F.G = gridDim.x; { const int bx = blockIdx.x; F.vcu = (F.G % 8 == 0) ? (bx % 8) * (F.G / 8) + bx / 8 : bx; } return F; }

__device__ __forceinline__ float wave_sum(float v) {
#pragma unroll
    for (int o = 1; o < 64; o <<= 1) v += __shfl_xor(v, o);
    return v;
}
__device__ __forceinline__ int seq_of(int m) { return m < MP ? (m >> 11) : 8; }
__device__ __forceinline__ int pos_of(int m) { return m < MP ? (m & (SEQP - 1)) : (m - MP); }
__device__ __forceinline__ const float* xrow(const float* xp, const float* xs, int m) { return m < MP ? xp + (size_t)m * DM : xs + (size_t)(m - MP) * DM; }

__device__ __forceinline__ int inA_logical(int np) {
    const int pn = np >> 8, c = np & 255;
    return (c < 128 ? 10240 : 14336) + 128 * pn + (c & 127);
}
__device__ __forceinline__ int inB_logical(int np) {
    if (np < 6144) return np;
    if (np < 10240) return np + 12288;
    const int pn = (np - 10240) >> 8, c = np & 255;
    return (c < 128 ? 6144 : 22528) + 128 * pn + (c & 127);
}
__device__ __forceinline__ int up_logical(int np) { const int pn = np >> 8, c = np & 255; return (c < 128 ? 0 : DFF) + 128 * pn + (c & 127); }

__device__ __forceinline__ int qk_perm6(int d) { return (d & 3) | (((d >> 5) & 1) << 2) | (((d >> 2) & 3) << 3) | (((d >> 4) & 1) << 5); }
template <bool QKP> __device__ __forceinline__ void transpose_item(const float* W, int K, int N, bf16* WT, int k0, int nlog0, int nphys0, LAS float* scr, int lane) {
    const float* src = W + (size_t)k0 * N + nlog0 + lane;
#pragma unroll 16
    for (int i = 0; i < 64; ++i) scr[i * 65 + lane] = src[(size_t)i * N];
    LDS_WAIT(); asm volatile("" ::: "memory");
    const int c = lane & 7, n8 = lane >> 3;
#pragma unroll
    for (int j = 0; j < 8; ++j) { const int n = n8 + 8 * j; const LAS float* s = scr + (8 * c) * 65 + n;
        u32x4 o; o.x = pk2(s[0], s[65]); o.y = pk2(s[2 * 65], s[3 * 65]); o.z = pk2(s[4 * 65], s[5 * 65]); o.w = pk2(s[6 * 65], s[7 * 65]);
        *(GAS u32x4*)(WT + (size_t)(nphys0 + (QKP ? qk_perm6(n) : n)) * K + k0 + 8 * c) = o; }
    LDS_WAIT(); asm volatile("" ::: "memory");
}

__device__ __forceinline__ void amax_item(bool QKP, const float* W, int N, int k0, int nlog0, int nphys0, unsigned* camax, int lane) {
    const float* src = W + (size_t)k0 * N + nlog0 + lane; float m = 0.f;
#pragma unroll 8
    for (int i = 0; i < 64; ++i) m = fmaxf(m, fabsf(src[(size_t)i * N]));
    (void)__hip_atomic_fetch_max(camax + nphys0 + (QKP ? qk_perm6(lane) : lane), __float_as_uint(m), __ATOMIC_RELAXED, __HIP_MEMORY_SCOPE_AGENT);
}
template <bool SAT> __device__ __forceinline__ unsigned pack_q8s(float a, float b, float c, float d, float s) {
    const float M = 12582912.0f; float ya, yb, yc, yd;
    if (SAT) { ya = __builtin_amdgcn_fmed3f(a * s, -127.f, 127.f) + M; yb = __builtin_amdgcn_fmed3f(b * s, -127.f, 127.f) + M; yc = __builtin_amdgcn_fmed3f(c * s, -127.f, 127.f) + M; yd = __builtin_amdgcn_fmed3f(d * s, -127.f, 127.f) + M; }
    else { ya = fmaf(a, s, M); yb = fmaf(b, s, M); yc = fmaf(c, s, M); yd = fmaf(d, s, M); }
    return __builtin_amdgcn_perm(__float_as_uint(yb), __float_as_uint(ya), 0x0c0c0400u) | __builtin_amdgcn_perm(__float_as_uint(yd), __float_as_uint(yc), 0x04000c0cu);
}
__device__ __forceinline__ unsigned pack_q8(float a, float b, float c, float d) { return pack_q8s<true>(a, b, c, d, 1.0f); }
__device__ __forceinline__ void transpose_item_i8(bool QKP, const float* W, int K, int N, signed char* W8, int k0, int nlog0, int nphys0, const unsigned* camax, float* swp, LAS float* scr, int lane) {
    const float* src = W + (size_t)k0 * N + nlog0 + lane;
#pragma unroll 16
    for (int i = 0; i < 64; ++i) scr[i * 65 + lane] = src[(size_t)i * N];
    LDS_WAIT(); asm volatile("" ::: "memory");
    const int c = lane & 3, n16 = lane >> 2;
#pragma unroll
    for (int j = 0; j < 4; ++j) { const int n = n16 + 16 * j, np = nphys0 + (QKP ? qk_perm6(n) : n); const LAS float* sp = scr + (16 * c) * 65 + n;
        const float amax = __uint_as_float(camax[np]), inv = amax > 0.f ? 127.0f / amax : 0.f;
        u32x4 o; o.x = pack_q8(sp[0] * inv, sp[65] * inv, sp[2 * 65] * inv, sp[3 * 65] * inv); o.y = pack_q8(sp[4 * 65] * inv, sp[5 * 65] * inv, sp[6 * 65] * inv, sp[7 * 65] * inv);
        o.z = pack_q8(sp[8 * 65] * inv, sp[9 * 65] * inv, sp[10 * 65] * inv, sp[11 * 65] * inv); o.w = pack_q8(sp[12 * 65] * inv, sp[13 * 65] * inv, sp[14 * 65] * inv, sp[15 * 65] * inv);
        *(GAS u32x4*)(W8 + (size_t)np * K + k0 + 16 * c) = o;
        if (k0 == 0 && c == 0) swp[np] = amax * (1.0f / 127.0f); }
    LDS_WAIT(); asm volatile("" ::: "memory");
}

__device__ __forceinline__ void fwht64(float (&v)[64]) {
#pragma unroll
    for (int st = 1; st < 64; st <<= 1)
#pragma unroll
        for (int i = 0; i < 64; ++i) if (!(i & st)) { const float a = v[i], b = v[i + st]; v[i] = a + b; v[i + st] = a - b; }
}
__device__ __forceinline__ f32x4 fwht64_row(f32x4 x, int lane) {
    { const float a = x[0] + x[1], b = x[0] - x[1], c = x[2] + x[3], d = x[2] - x[3]; x[0] = a + c; x[1] = b + d; x[2] = a - c; x[3] = b - d; }
#define FW_DPP(v, ctrl) __int_as_float(__builtin_amdgcn_update_dpp(0, __float_as_int(v), (ctrl), 0xf, 0xf, true))
#pragma unroll
    for (int e = 0; e < 4; ++e) { float own = x[e], pr;
        pr = FW_DPP(own, 0xB1); own = (lane & 1) ? pr - own : own + pr;
        pr = FW_DPP(own, 0x4E); own = (lane & 2) ? pr - own : own + pr;
        { const float up = FW_DPP(own, 0x104), dn = FW_DPP(own, 0x114); own = (lane & 4) ? dn - own : own + up; }
        { const float up = FW_DPP(own, 0x108), dn = FW_DPP(own, 0x118); own = (lane & 8) ? dn - own : own + up; }
        x[e] = own; }
#undef FW_DPP
    return x;
}
__device__ __forceinline__ void amax_item_h(bool QKP, const float* W, int N, int k0, int nlog0, int nphys0, unsigned* camax, int lane) {
    const float* src = W + (size_t)k0 * N + nlog0 + lane; float v[64];
#pragma unroll
    for (int i = 0; i < 64; ++i) v[i] = src[(size_t)i * N];
    fwht64(v); float m = 0.f;
#pragma unroll
    for (int i = 0; i < 64; ++i) m = fmaxf(m, fabsf(v[i]));
    (void)__hip_atomic_fetch_max(camax + nphys0 + (QKP ? qk_perm6(lane) : lane), __float_as_uint(m), __ATOMIC_RELAXED, __HIP_MEMORY_SCOPE_AGENT);
}
__device__ __forceinline__ void transpose_item_i8_h(bool QKP, const float* W, int K, int N, signed char* W8, int k0, int nlog0, int nphys0, const unsigned* camax, float* swp, int lane) {
    const float* src = W + (size_t)k0 * N + nlog0 + lane; float v[64];
#pragma unroll
    for (int i = 0; i < 64; ++i) v[i] = src[(size_t)i * N];
    fwht64(v);
    const int np = nphys0 + (QKP ? qk_perm6(lane) : lane); const float amax = AMX_SAFETY * __uint_as_float(camax[np]), inv = amax > 0.f ? 127.0f / amax : 0.f;
    GAS u32x4* dst = (GAS u32x4*)(W8 + (size_t)np * K + k0);
#pragma unroll
    for (int q = 0; q < 4; ++q) { u32x4 o; o.x = pack_q8s<true>(v[16 * q], v[16 * q + 1], v[16 * q + 2], v[16 * q + 3], inv); o.y = pack_q8s<true>(v[16 * q + 4], v[16 * q + 5], v[16 * q + 6], v[16 * q + 7], inv);
        o.z = pack_q8s<true>(v[16 * q + 8], v[16 * q + 9], v[16 * q + 10], v[16 * q + 11], inv); o.w = pack_q8s<true>(v[16 * q + 12], v[16 * q + 13], v[16 * q + 14], v[16 * q + 15], inv); dst[q] = o; }
    if (k0 == 0) swp[np] = amax * (1.0f / (127.0f * 64.0f));
}

__device__ __forceinline__ void transpose_item_i8_h2(bool QKP, const float* W, int K, int N, signed char* W8, int k0, int nlog0, int nphys0, const unsigned* camax, float* swp, int lane) {
    const float* src = W + (size_t)k0 * N + nlog0 + lane; float va[64], vb[64];
#pragma unroll
    for (int i = 0; i < 64; ++i) va[i] = src[(size_t)i * N];
#pragma unroll
    for (int i = 0; i < 64; ++i) vb[i] = src[(size_t)(64 + i) * N];
    fwht64(va); fwht64(vb);
    const int np = nphys0 + (QKP ? qk_perm6(lane) : lane); const float amax = AMX_SAFETY * __uint_as_float(camax[np]), inv = amax > 0.f ? 127.0f / amax : 0.f;
    GAS u32x4* dst = (GAS u32x4*)(W8 + (size_t)np * K + k0);
#pragma unroll
    for (int q = 0; q < 4; ++q) { u32x4 o; o.x = pack_q8s<true>(va[16 * q], va[16 * q + 1], va[16 * q + 2], va[16 * q + 3], inv); o.y = pack_q8s<true>(va[16 * q + 4], va[16 * q + 5], va[16 * q + 6], va[16 * q + 7], inv);
        o.z = pack_q8s<true>(va[16 * q + 8], va[16 * q + 9], va[16 * q + 10], va[16 * q + 11], inv); o.w = pack_q8s<true>(va[16 * q + 12], va[16 * q + 13], va[16 * q + 14], va[16 * q + 15], inv); dst[q] = o; }
#pragma unroll
    for (int q = 0; q < 4; ++q) { u32x4 o; o.x = pack_q8s<true>(vb[16 * q], vb[16 * q + 1], vb[16 * q + 2], vb[16 * q + 3], inv); o.y = pack_q8s<true>(vb[16 * q + 4], vb[16 * q + 5], vb[16 * q + 6], vb[16 * q + 7], inv);
        o.z = pack_q8s<true>(vb[16 * q + 8], vb[16 * q + 9], vb[16 * q + 10], vb[16 * q + 11], inv); o.w = pack_q8s<true>(vb[16 * q + 12], vb[16 * q + 13], vb[16 * q + 14], vb[16 * q + 15], inv); dst[4 + q] = o; }
    if (k0 == 0) swp[np] = amax * (1.0f / (127.0f * 64.0f));
}

__device__ __forceinline__ void sincos_d(double a, double& s, double& c) {
    const double TWO_PI_HI = 6.283185307179586, TWO_PI_LO = 2.4492935982947064e-16;
    const double k = __builtin_rint(a * 0.15915494309189535);
    double r = __builtin_fma(-k, TWO_PI_HI, a); r = __builtin_fma(-k, TWO_PI_LO, r);
    const double q = r * 0.25, z = q * q;
    double sp = -1.0 / 1307674368000.0; sp = sp * z + 1.0 / 6227020800.0; sp = sp * z - 1.0 / 39916800.0; sp = sp * z + 1.0 / 362880.0; sp = sp * z - 1.0 / 5040.0; sp = sp * z + 1.0 / 120.0; sp = sp * z - 1.0 / 6.0; sp = sp * z + 1.0;
    double cp = 1.0 / 20922789888000.0; cp = cp * z - 1.0 / 87178291200.0; cp = cp * z + 1.0 / 479001600.0; cp = cp * z - 1.0 / 3628800.0; cp = cp * z + 1.0 / 40320.0; cp = cp * z - 1.0 / 720.0; cp = cp * z + 1.0 / 24.0; cp = cp * z - 0.5; cp = cp * z + 1.0;
    double s1 = q * sp, c1 = cp;
    double s2 = 2.0 * s1 * c1, c2 = 1.0 - 2.0 * s1 * s1;
    s = 2.0 * s2 * c2; c = 1.0 - 2.0 * s2 * s2;
}

__device__ __forceinline__ void phase0(LAS unsigned char* lds_) {
    const ArgsP ap = kargs(); Frame F = make_frame(lds_);
    unsigned char* ws = ap->ws;
    { const int idx = blockIdx.x * 512 + F.tid;
      if (idx < 4096) { const int pos = idx >> 5, f = idx & 31; double inv = 1.0; for (int i = 0; i < f; ++i) inv *= 0.7498942093324558;
          double s, c; sincos_d((double)pos * inv, s, c); float* rope = (float*)(ws + WS_ROPE); rope[idx] = (float)c; rope[4096 + idx] = (float)s; } }
    float* mod = (float*)(ws + WS_MOD);
    {
        LAS float* sc = (LAS float*)(F.lds + F.wave * 6144);
        LAS float* RED = (LAS float*)(F.lds + 49152);
        const int sub = F.lane / 24, c4 = F.lane - 24 * sub; const bool actv = F.lane < 48; const int kw0 = F.wave * 512;
        for (int cb = blockIdx.x; cb < (6 * DM) / 96; cb += F.G) {
            const int n0 = cb * 96;
            f32x4 acc[9];
#pragma unroll
            for (int sq = 0; sq < 9; ++sq) acc[sq] = (f32x4){0.f, 0.f, 0.f, 0.f};
            for (int kc = 0; kc < 512; kc += 128) {
                for (int idx = F.lane; idx < 128 * 9; idx += 64) { const int k = idx / 9, sq = idx - 9 * k; const float c = sq < 8 ? ap->cp[sq * DM + kw0 + kc + k] : ap->cs[kw0 + kc + k]; sc[k * 12 + sq] = c / (1.0f + __expf(-c)); }
                LDS_WAIT(); asm volatile("" ::: "memory");
                if (actv) { const float* wp = ap->w_ada + (size_t)(kw0 + kc + sub) * (6 * DM) + n0 + 4 * c4;
#pragma unroll 8
                    for (int it = 0; it < 64; ++it) {
                        const f32x4 w = *(const f32x4*)(wp + (size_t)it * (2 * 6 * DM)); const LAS float* sr = sc + (2 * it + sub) * 12;
                        const f32x4 s0 = *(const LAS f32x4*)sr, s1 = *(const LAS f32x4*)(sr + 4), s2 = *(const LAS f32x4*)(sr + 8);
                        acc[0] += s0[0] * w; acc[1] += s0[1] * w; acc[2] += s0[2] * w; acc[3] += s0[3] * w;
                        acc[4] += s1[0] * w; acc[5] += s1[1] * w; acc[6] += s1[2] * w; acc[7] += s1[3] * w; acc[8] += s2[0] * w; } }
                LDS_WAIT(); asm volatile("" ::: "memory");
            }
            if (actv) {
#pragma unroll
                for (int sq = 0; sq < 9; ++sq) *(LAS f32x4*)(RED + ((F.wave * 2 + sub) * 9 + sq) * 96 + 4 * c4) = acc[sq]; }
            __syncthreads();
            for (int t = F.tid; t < 9 * 96; t += 512) { const int sq = t / 96, c = t - 96 * sq; float sum = ap->b_ada[n0 + c];
#pragma unroll
                for (int p = 0; p < 16; ++p) sum += RED[(p * 9 + sq) * 96 + c];
                mod[(size_t)sq * (6 * DM) + n0 + c] = sum; }
            __syncthreads();
        }
    }
    __syncthreads();
    LAS float* scr = (LAS float*)(F.lds + F.wave * TR_SCR);
    const int gw = F.vcu * 8 + F.wave, NGW = F.G * 8;
    constexpr int I_INA = 64 * (NINA / 64), I_AMX = 64 * (NINB / 64), I_O = 64 * 64;
    unsigned* camax = (unsigned*)(ws + WS_CAMAX);
    for (int it = gw; it < I_INA; it += NGW) { const int nb = NINA / 64, kb = it / nb, nbk = it - kb * nb; transpose_item<false>(ap->w_in, DM, NIN, (bf16*)(ws + WS_WIN), kb * 64, inA_logical(nbk * 64), nbk * 64, scr, F.lane); }
    if (T8 < NT_UP) for (int it = (gw + 1536) % NGW; it < 64 * (NT_UP - T8) * 4; it += NGW) { const int nb = (NT_UP - T8) * 4, kb = it / nb, np0 = T8 * 256 + (it - kb * nb) * 64; transpose_item<false>(ap->w_up, DM, NUP, (bf16*)(ws + WS_WUP), kb * 64, up_logical(np0), np0, scr, F.lane); }
    if (T8 > 0) { unsigned* camax2 = (unsigned*)(ws + WS_CAMAX2);
        for (int it = (gw + 1536) % NGW; it < (64 / AMX_STRIDE) * T8 * 4; it += NGW) { const int nb = T8 * 4, kb = (it / nb) * AMX_STRIDE, np0 = (it - (it / nb) * nb) * 64; if (UP_ROT) amax_item_h(false, ap->w_up, NUP, kb * 64, up_logical(np0), np0, camax2, F.lane); else amax_item(false, ap->w_up, NUP, kb * 64, up_logical(np0), np0, camax2, F.lane); } }
    for (int it = gw; it < I_O; it += NGW) { const int kb = it >> 6, nbk = it & 63; transpose_item<false>(ap->w_o, DM, DM, (bf16*)(ws + WS_WO), kb * 64, nbk * 64, nbk * 64, scr, F.lane); }
    { unsigned* camax3 = (unsigned*)(ws + WS_CAMAX3);
        for (int it = (gw + 512) % NGW; it < ((DFF / 64 + AMX_STRIDE - 1) / AMX_STRIDE) * 64; it += NGW) { const int kb = (it >> 6) * AMX_STRIDE, nbk = it & 63; amax_item_h(false, ap->w_down, DM, kb * 64, nbk * 64, nbk * 64, camax3, F.lane); } }
    for (int it = gw; it < I_AMX / AMX_STRIDE; it += NGW) { const int nb = NINB / 64, kb = (it / nb) * AMX_STRIDE, nbk = it - (it / nb) * nb;
        amax_item_h(nbk < 80, ap->w_in, NIN, kb * 64, inB_logical(nbk * 64), nbk * 64, camax, F.lane); }
}

__device__ __forceinline__ void tail_copy_wdown(LAS unsigned char* lds_, int nwg) {
    const ArgsP ap = kargs(); Frame F = make_frame(lds_);
    const int G = F.G, extra = nwg % G, bx = blockIdx.x;
    if (extra == 0 || bx < extra) return;
    const int nb = G - extra, gw = (bx - extra) * 8 + F.wave, NGW = nb * 8;
    LAS float* scr = (LAS float*)(F.lds + F.wave * TR_SCR);
    for (int it = gw; it < (DFF / 64) * 64; it += NGW) { const int kb = it >> 6, nbk = it & 63; transpose_item_i8_h(false, ap->w_down, DFF, DM, (signed char*)(ap->ws + WS_WDN), kb * 64, nbk * 64, nbk * 64, (const unsigned*)(ap->ws + WS_CAMAX3), (float*)(ap->ws + WS_SWD), F.lane); }
}

__device__ __forceinline__ void v8t_pass(LAS unsigned char* lds_) {
    const ArgsP ap = kargs(); Frame F = make_frame(lds_);
    const bf16* V = (const bf16*)(ap->ws + WS_V); unsigned char* V8T = ap->ws + WS_V8T;
    LAS unsigned char* T = F.lds + F.wave * TR_SCR;
    const int gw = F.vcu * 8 + F.wave, NGW = F.G * 8;
    for (int it = gw; it < 8 * (MROWS / 64); it += NGW) {
        const int kvh = it & 7, tile = it >> 3;
        const bf16* src = V + (size_t)tile * 64 * KVD + kvh * 128 + (F.lane & 15) * 8;
#pragma unroll 4
        for (int ps = 0; ps < 16; ++ps) {
            const int kap = 4 * ps + (F.lane >> 4);
            const u32x4 w = *(const u32x4*)(src + (size_t)kap * KVD);
            const int pos = 32 * ((kap >> 2) & 1) + 16 * (kap >> 5) + (kap & 3) + 4 * ((kap & 31) >> 3);
            const int lo = att::cvt4_fp8(att::bflo(w.x), att::bfhi(w.x), att::bflo(w.y), att::bfhi(w.y)), hi4 = att::cvt4_fp8(att::bflo(w.z), att::bfhi(w.z), att::bflo(w.w), att::bfhi(w.w));
            LAS unsigned char* t = T + ((F.lane & 15) * 8) * 80 + pos;
            t[0] = (unsigned char)lo; t[80] = (unsigned char)(lo >> 8); t[160] = (unsigned char)(lo >> 16); t[240] = (unsigned char)(lo >> 24);
            t[320] = (unsigned char)hi4; t[400] = (unsigned char)(hi4 >> 8); t[480] = (unsigned char)(hi4 >> 16); t[560] = (unsigned char)(hi4 >> 24);
        }
        LDS_WAIT(); asm volatile("" ::: "memory");
        unsigned char* dst = V8T + (size_t)(kvh * (MROWS / 64) + tile) * 8192;
#pragma unroll
        for (int q = 0; q < 8; ++q) { const int id = q * 64 + F.lane; *(u32x4*)(dst + id * 16) = *(const LAS u32x4*)(T + (id >> 2) * 80 + (id & 3) * 16); }
        LDS_WAIT(); asm volatile("" ::: "memory");
    }
}

__device__ __forceinline__ void phase_rows_u(LAS unsigned char* lds_) {
    const ArgsP ap = kargs(); Frame F = make_frame(lds_);
    const int gw = F.vcu * 8 + F.wave, NGW = F.G * 8; const float* mod = (const float*)(ap->ws + WS_MOD); bf16* U = (bf16*)(ap->ws + WS_U);
    unsigned char* U8 = (unsigned char*)ap->out + OUT_U8; float* SU = (float*)(ap->ws + WS_SU);
    {
        LAS float* scr = (LAS float*)(F.lds + F.wave * TR_SCR); const unsigned* camax = (const unsigned*)(ap->ws + WS_CAMAX); float* swp = (float*)(ap->ws + WS_SWP); signed char* W8 = (signed char*)(ap->ws + WS_W8);
        for (int it = gw; it < 32 * (NINB / 64); it += NGW) { const int nb = NINB / 64, kb = it / nb, nbk = it - kb * nb;
            transpose_item_i8_h2(nbk < 80, ap->w_in, DM, NIN, W8, kb * 128, inB_logical(nbk * 64), nbk * 64, camax, swp, F.lane); }        if (T8 > 0) { const unsigned* camax2 = (const unsigned*)(ap->ws + WS_CAMAX2); float* swpu = (float*)(ap->ws + WS_SWPU); signed char* W8U = (signed char*)(ap->ws + WS_WUP);
            for (int it = (gw + 1024) % NGW; it < (UP_ROT ? 32 : 64) * T8 * 4; it += NGW) { const int nb = T8 * 4, kb = it / nb, np0 = (it - kb * nb) * 64; if (UP_ROT) transpose_item_i8_h2(false, ap->w_up, DM, NUP, W8U, kb * 128, up_logical(np0), np0, camax2, swpu, F.lane); else transpose_item_i8(false, ap->w_up, DM, NUP, W8U, kb * 64, up_logical(np0), np0, camax2, swpu, scr, F.lane); } }
    }
    for (int m = gw; m < MROWS; m += NGW) {
        const f32x4* xr = (const f32x4*)xrow(ap->xp, ap->xs, m) + F.lane; const float* md = mod + (size_t)seq_of(m) * (6 * DM);
        f32x4 v[16]; float s = 0.f;
#pragma unroll
        for (int j = 0; j < 16; ++j) { v[j] = xr[64 * j]; s += (v[j][0] * v[j][0] + v[j][1] * v[j][1]) + (v[j][2] * v[j][2] + v[j][3] * v[j][3]); }
        const float rstd = 1.0f / sqrtf(wave_sum(s) * (1.0f / DM) + NORM_EPS); float am = 0.f;
#pragma unroll
        for (int j = 0; j < 16; ++j) { const int ch = 4 * (F.lane + 64 * j);
            const f32x4 g = *(const f32x4*)(ap->g_mix_pre + ch), sh = *(const f32x4*)(md + ch), scl = *(const f32x4*)(md + DM + ch);
            const f32x4 u = (v[j] * rstd) * g * (1.0f + scl) + sh;
            u32x2 w; w.x = pk2(u[0], u[1]); w.y = pk2(u[2], u[3]); *(u32x2*)(U + (size_t)m * DM + ch) = w;
            const f32x4 r = fwht64_row(u, F.lane); v[j] = r;
            am = fmaxf(fmaxf(am, fmaxf(fabsf(r[0]), fabsf(r[1]))), fmaxf(fabsf(r[2]), fabsf(r[3]))); }
#pragma unroll
        for (int o = 1; o < 64; o <<= 1) am = fmaxf(am, __shfl_xor(am, o));
        const float inv = am > 0.f ? 127.0f / am : 0.f;
        if (F.lane == 0) SU[m] = am * (1.0f / 127.0f);
#pragma unroll
        for (int j = 0; j < 16; ++j) *(unsigned*)(U8 + (size_t)m * DM + 4 * (F.lane + 64 * j)) = pack_q8s<false>(v[j][0], v[j][1], v[j][2], v[j][3], inv);
    }
}

__device__ __forceinline__ void hadamard_frags(bf16x8 (&HA)[8], int lane) {
    const int fr = lane & 15, fq = lane >> 4;
#pragma unroll
    for (int mi = 0; mi < 4; ++mi)
#pragma unroll
        for (int ks = 0; ks < 2; ++ks) { bf16x8 a;
#pragma unroll
            for (int i = 0; i < 8; ++i) a[i] = (short)((__builtin_popcount((16 * mi + fr) & (32 * ks + 8 * fq + i)) & 1) ? 0xBF80 : 0x3F80);
            HA[2 * mi + ks] = a; }
}
__device__ __forceinline__ void hadamard_rows_mfma(f32x4 (&C)[16], const bf16x8 (&HA)[8], LAS unsigned char* buf, int lane) {
    const int fr = lane & 15, fq = lane >> 4;
    bf16x8 B[8];
#pragma unroll
    for (int nj = 0; nj < 4; ++nj)
#pragma unroll
        for (int ks = 0; ks < 2; ++ks) B[2 * nj + ks] = *(const LAS bf16x8*)(buf + (16 * nj + fr) * 144 + (32 * ks + 8 * fq) * 2);
#pragma unroll
    for (int mi = 0; mi < 4; ++mi)
#pragma unroll
        for (int nj = 0; nj < 4; ++nj) { f32x4 c = {0.f, 0.f, 0.f, 0.f};
            c = __builtin_amdgcn_mfma_f32_16x16x32_bf16(HA[2 * mi], B[2 * nj], c, 0, 0, 0); c = __builtin_amdgcn_mfma_f32_16x16x32_bf16(HA[2 * mi + 1], B[2 * nj + 1], c, 0, 0, 0);
            C[4 * mi + nj] = c; }
}
__device__ __forceinline__ void phase_rows_mid(LAS unsigned char* lds_) {
    const ArgsP ap = kargs(); Frame F = make_frame(lds_);
    const float* mod = (const float*)(ap->ws + WS_MOD); bf16* U = (bf16*)(ap->ws + WS_U); const bf16* OUT = (const bf16*)(ap->ws + WS_OUT);
    unsigned char* U28 = ap->ws + WS_U28; float* SU2 = (float*)(ap->ws + WS_SU2);
    LAS f32x4* VL = (LAS f32x4*)F.lds;
    LAS unsigned char* hb = F.lds + 49152 + F.wave * 9216;
    bf16x8 HA[8]; hadamard_frags(HA, F.lane);
    const int NSTEP = (MROWS / 8 + F.G - 1) / F.G;
    int cur = -1;
    f32x4 xv[16];
    { const int mf = F.vcu * NSTEP * 8 + F.wave; if (mf < MROWS) { const f32x4* xr0 = (const f32x4*)xrow(ap->xp, ap->xs, mf) + F.lane;
#pragma unroll
        for (int j = 0; j < 16; ++j) xv[j] = xr0[64 * j]; } }
    for (int i = 0; i < NSTEP; ++i) {
        const int m0 = (F.vcu * NSTEP + i) * 8; if (m0 >= MROWS) break;
        const int m = m0 + F.wave, sq = seq_of(m0), mnx = (i + 1 < NSTEP && m0 + 8 < MROWS) ? m + 8 : m;
        if (sq != cur) {
            __syncthreads();
            const f32x4* md4 = (const f32x4*)(mod + (size_t)sq * (6 * DM)); const f32x4* gpo = (const f32x4*)ap->g_mix_post; const f32x4* gfp = (const f32x4*)ap->g_ffn_pre;
            for (int c = F.tid; c < 1024; c += 512) { VL[c] = md4[2 * 1024 + c] * gpo[c]; VL[1024 + c] = gfp[c] * (1.0f + md4[4 * 1024 + c]); VL[2048 + c] = md4[3 * 1024 + c]; }
            __syncthreads(); cur = sq;
        }
        f32x4 h[16]; float s = 0.f;
#pragma unroll
        for (int j = 0; j < 16; ++j) { const u32x2 w = *(const u32x2*)(OUT + (size_t)m * DM + 4 * (F.lane + 64 * j)); h[j] = (f32x4){bflo(w.x), bfhi(w.x), bflo(w.y), bfhi(w.y)};
            s += (h[j][0] * h[j][0] + h[j][1] * h[j][1]) + (h[j][2] * h[j][2] + h[j][3] * h[j][3]); }
        const float rstd1 = 1.0f / sqrtf(wave_sum(s) * (1.0f / DM) + NORM_EPS);
        float s2 = 0.f;
#pragma unroll
        for (int j = 0; j < 16; ++j) { const int c = F.lane + 64 * j;
            h[j] = xv[j] + VL[c] * (h[j] * rstd1);
            { u32x2 hw; hw.x = pk2(h[j][0], h[j][1]); hw.y = pk2(h[j][2], h[j][3]); *(u32x2*)(U + (size_t)m * DM + 4 * c) = hw; }
            s2 += (h[j][0] * h[j][0] + h[j][1] * h[j][1]) + (h[j][2] * h[j][2] + h[j][3] * h[j][3]); }
        { const f32x4* xrn = (const f32x4*)xrow(ap->xp, ap->xs, mnx) + F.lane;
#pragma unroll
          for (int j = 0; j < 16; ++j) xv[j] = xrn[64 * j]; }
        const float rstd2 = 1.0f / sqrtf(wave_sum(s2) * (1.0f / DM) + NORM_EPS); float am = 0.f;
#pragma unroll
        for (int j = 0; j < 16; ++j) { const int c = F.lane + 64 * j;
            const f32x4 u = (h[j] * rstd2) * VL[1024 + c] + VL[2048 + c];
            u32x2 w; w.x = pk2(u[0], u[1]); w.y = pk2(u[2], u[3]);
            *(LAS u32x2*)(hb + (4 * j + (F.lane >> 4)) * 144 + (F.lane & 15) * 8) = w; }
        LDS_WAIT();
        f32x4 C[16]; hadamard_rows_mfma(C, HA, hb, F.lane);
#pragma unroll
        for (int t = 0; t < 16; ++t) am = fmaxf(fmaxf(am, fmaxf(fabsf(C[t][0]), fabsf(C[t][1]))), fmaxf(fabsf(C[t][2]), fabsf(C[t][3])));
#pragma unroll
        for (int o = 1; o < 64; o <<= 1) am = fmaxf(am, __shfl_xor(am, o));
        const float inv = am > 0.f ? 127.0f / am : 0.f;
        if (F.lane == 0) SU2[m] = am * (1.0f / 127.0f);
        LDS_WAIT();
#pragma unroll
        for (int mi = 0; mi < 4; ++mi)
#pragma unroll
            for (int nj = 0; nj < 4; ++nj) { const f32x4 c = C[4 * mi + nj];
                *(LAS unsigned*)(hb + (16 * nj + (F.lane & 15)) * 64 + 16 * mi + 4 * (F.lane >> 4)) = pack_q8s<false>(c[0], c[1], c[2], c[3], inv); }
        LDS_WAIT();
#pragma unroll
        for (int q = 0; q < 4; ++q) *(u32x4*)(U28 + (size_t)m * DM + q * 1024 + F.lane * 16) = *(const LAS u32x4*)(hb + q * 1024 + F.lane * 16);
        LDS_WAIT();
    }
    __syncthreads();
}

__device__ __forceinline__ void phase_fixup(LAS unsigned char* lds_) {
    const ArgsP ap = kargs(); Frame F = make_frame(lds_);
    const int gw = F.vcu * 8 + F.wave, NGW = F.G * 8; const float* SB = (const float*)(ap->ws + WS_SB); bf16* ACT = (bf16*)(ap->ws + WS_ACT);
    constexpr int NCB = 22, NSTRIP = MROWS / 128;
    for (int it = gw; it < NSTRIP * 2 * NCB; it += NGW) {
        const int cb = it % NCB, sl = it / NCB, strip = sl >> 1, last = sl & 1, f0 = cb * 512 + F.lane * 8;
        if (f0 >= DFF) continue;
        const int row = strip * 128 + (last ? 127 : 0), seqlen = row < MP ? SEQP : SEQS, t = row < MP ? (row & (SEQP - 1)) : (row - MP);
        const bool has_nb = last ? (t != seqlen - 1) : (t != 0);
        const int pc = 256 * (f0 >> 7) + (f0 & 127);
        const float* part = SB + ((size_t)strip * 4 + (last ? 3 : 2)) * NUP + pc;
        const float* nb = SB + ((size_t)(last ? strip + 1 : strip - 1) * 4 + (last ? 0 : 1)) * NUP + pc;
        const float* wrow = ap->ffn_conv_w + (last ? 2 * NUP : 0);
        float ov[8];
#pragma unroll
        for (int h = 0; h < 2; ++h) {
            const f32x4 pa = *(const f32x4*)(part + 4 * h), pb = *(const f32x4*)(part + 128 + 4 * h);
            f32x4 na = (f32x4){0.f, 0.f, 0.f, 0.f}, nbv = na;
            if (has_nb) { na = *(const f32x4*)(nb + 4 * h); nbv = *(const f32x4*)(nb + 128 + 4 * h); }
            const f32x4 wa = *(const f32x4*)(wrow + f0 + 4 * h), wb = *(const f32x4*)(wrow + DFF + f0 + 4 * h);
            const f32x4 za = pa + wa * na, zb = pb + wb * nbv;
#pragma unroll
            for (int e = 0; e < 4; ++e) ov[4 * h + e] = za[e] * __builtin_amdgcn_rcpf(1.0f + __builtin_amdgcn_exp2f(-1.4426950408889634f * za[e])) * zb[e];
        }
        u32x4 w; w.x = pk2(ov[0], ov[1]); w.y = pk2(ov[2], ov[3]); w.z = pk2(ov[4], ov[5]); w.w = pk2(ov[6], ov[7]);
        *(u32x4*)(ACT + (size_t)row * DFF + f0) = w;
    }
}

__device__ __forceinline__ void phase_actq(LAS unsigned char* lds_) {
    const ArgsP ap = kargs(); Frame F = make_frame(lds_);
    const int gw = F.vcu * 8 + F.wave, NGW = F.G * 8; const bf16* ACT = (const bf16*)(ap->ws + WS_ACT); unsigned char* A8 = ap->ws + WS_ACT8; float* SA = (float*)(ap->ws + WS_SA);
    constexpr int NBLK = DFF / 64;
    bf16x8 HA[8]; hadamard_frags(HA, F.lane);
    LAS unsigned char* hb = F.lds + F.wave * 4096;
    const int fr = F.lane & 15, fq = F.lane >> 4;
    bf16x8 BB[24];
#define AQ_LOADB(ROW, CH) do { _Pragma("unroll") for (int nj = 0; nj < 4; ++nj) { int blk = 64 * (CH) + 16 * nj + fr; blk = blk < NBLK ? blk : NBLK - 1; \
        _Pragma("unroll") for (int ks = 0; ks < 2; ++ks) BB[8 * (CH) + 2 * nj + ks] = *(const bf16x8*)((ROW) + blk * 64 + 32 * ks + 8 * fq); } } while (0)
#define AQ_MMA(CH) do { _Pragma("unroll") for (int mi = 0; mi < 4; ++mi) _Pragma("unroll") for (int nj = 0; nj < 4; ++nj) { f32x4 c = {0.f, 0.f, 0.f, 0.f}; \
        c = __builtin_amdgcn_mfma_f32_16x16x32_bf16(HA[2 * mi], BB[8 * (CH) + 2 * nj], c, 0, 0, 0); c = __builtin_amdgcn_mfma_f32_16x16x32_bf16(HA[2 * mi + 1], BB[8 * (CH) + 2 * nj + 1], c, 0, 0, 0); C[4 * mi + nj] = c; } } while (0)
    if (gw < MROWS) { const bf16* row0 = ACT + (size_t)gw * DFF; AQ_LOADB(row0, 0); AQ_LOADB(row0, 1); AQ_LOADB(row0, 2); }
    for (int m = gw; m < MROWS; m += NGW) {
        const bf16* rown = ACT + (size_t)((m + NGW < MROWS) ? m + NGW : m) * DFF;
        float am = 0.f;
#pragma unroll
        for (int ch = 0; ch < 3; ++ch) { f32x4 C[16]; AQ_MMA(ch);
#pragma unroll
            for (int t = 0; t < 16; ++t) am = fmaxf(fmaxf(am, fmaxf(fabsf(C[t][0]), fabsf(C[t][1]))), fmaxf(fabsf(C[t][2]), fabsf(C[t][3]))); }
#pragma unroll
        for (int o = 1; o < 64; o <<= 1) am = fmaxf(am, __shfl_xor(am, o));
        const float inv = am > 0.f ? 127.0f / am : 0.f;
        if (F.lane == 0) SA[m] = am * (1.0f / 127.0f);
#pragma unroll
        for (int ch = 0; ch < 3; ++ch) { f32x4 C[16]; AQ_MMA(ch);
#pragma unroll
            for (int mi = 0; mi < 4; ++mi)
#pragma unroll
                for (int nj = 0; nj < 4; ++nj) { const f32x4 c = C[4 * mi + nj];
                    *(LAS unsigned*)(hb + (16 * nj + fr) * 64 + 16 * mi + 4 * fq) = pack_q8s<false>(c[0], c[1], c[2], c[3], inv); }
            AQ_LOADB(rown, ch);
            LDS_WAIT();
            const int nbytes = (ch < 2 ? 64 : NBLK - 128) * 64;
#pragma unroll
            for (int q = 0; q < 4; ++q) { const int off = q * 1024 + F.lane * 16; if (off < nbytes) *(u32x4*)(A8 + (size_t)m * DFF + ch * 4096 + off) = *(const LAS u32x4*)(hb + off); }
            LDS_WAIT();
        }
    }
#undef AQ_LOADB
#undef AQ_MMA
}

__device__ __forceinline__ void phase_rows_final(LAS unsigned char* lds_) {
    const ArgsP ap = kargs(); Frame F = make_frame(lds_);
    const float* mod = (const float*)(ap->ws + WS_MOD); const bf16* Y = (const bf16*)(ap->ws + WS_Y); const bf16* H1 = (const bf16*)(ap->ws + WS_U);
    LAS f32x4* VL = (LAS f32x4*)F.lds;
    const int NSTEP = (MROWS / 8 + F.G - 1) / F.G;
    int cur = -1;
    u32x2 yw[16], hw[16];
    { const int mf = F.vcu * NSTEP * 8 + F.wave; if (mf < MROWS) {
#pragma unroll
        for (int j = 0; j < 16; ++j) { yw[j] = *(const u32x2*)(Y + (size_t)mf * DM + 4 * (F.lane + 64 * j)); hw[j] = *(const u32x2*)(H1 + (size_t)mf * DM + 4 * (F.lane + 64 * j)); } } }
    for (int i = 0; i < NSTEP; ++i) {
        const int m0 = (F.vcu * NSTEP + i) * 8; if (m0 >= MROWS) break;
        const int m = m0 + F.wave, sq = seq_of(m0), mnx = (i + 1 < NSTEP && m0 + 8 < MROWS) ? m + 8 : m;
        if (sq != cur) {
            __syncthreads();
            const f32x4* md4 = (const f32x4*)(mod + (size_t)sq * (6 * DM)); const f32x4* gpo = (const f32x4*)ap->g_ffn_post;
            for (int c = F.tid; c < 1024; c += 512) VL[c] = md4[5 * 1024 + c] * gpo[c];
            __syncthreads(); cur = sq;
        }
        f32x4 h[16], r[16]; float s = 0.f;
#pragma unroll
        for (int j = 0; j < 16; ++j) { const u32x2 w = yw[j]; h[j] = (f32x4){bflo(w.x), bfhi(w.x), bflo(w.y), bfhi(w.y)}; const u32x2 q = hw[j]; r[j] = (f32x4){bflo(q.x), bfhi(q.x), bflo(q.y), bfhi(q.y)};
            s += (h[j][0] * h[j][0] + h[j][1] * h[j][1]) + (h[j][2] * h[j][2] + h[j][3] * h[j][3]); }
#pragma unroll
        for (int j = 0; j < 16; ++j) { yw[j] = *(const u32x2*)(Y + (size_t)mnx * DM + 4 * (F.lane + 64 * j)); hw[j] = *(const u32x2*)(H1 + (size_t)mnx * DM + 4 * (F.lane + 64 * j)); }
        const float rstd = 1.0f / sqrtf(wave_sum(s) * (1.0f / DM) + NORM_EPS);
#pragma unroll
        for (int j = 0; j < 16; ++j) { const int c = F.lane + 64 * j; *(f32x4*)(ap->out + (size_t)m * DM + 4 * c) = r[j] + VL[c] * (h[j] * rstd); }
    }
    __syncthreads();
}

constexpr int NPHASE = 12;
__global__ void __launch_bounds__(512, 2) fwd_kernel(Args args) {
    extern __shared__ __attribute__((aligned(16))) unsigned char lds[];
    LAS unsigned char* L = (LAS unsigned char*)lds;
    volatile LAS unsigned* MISC = (volatile LAS unsigned*)(L + LDSCTL_OFF);
    for (int u = threadIdx.x; u < (LDS_BYTES - LDSCTL_OFF) / 4; u += 512) ((LAS unsigned*)(L + LDSCTL_OFF))[u] = 0u;
    __syncthreads();
    XcdBarrier bar; bar.bar = (unsigned*)(args.ws + WS_CTL) + CW_BAR; bar.x = 0; bar.st = nullptr;
#if !MK_PER_PHASE
    bar = xcd_barrier_post((unsigned*)(args.ws + WS_CTL) + CW_BAR, MISC + 8);
#endif
#ifndef PH_MASK
#define PH_MASK 0xffff
#endif
#if MK_PER_PHASE
    const int lo = args.ph_lo, hi = args.ph_hi;
#define IN(k) (((PH_MASK >> (k)) & 1) && lo <= (k) && (k) < hi)
#define SEAM(k) do { } while (0)
#else
#define IN(k) ((PH_MASK >> (k)) & 1)
#define SEAM(k) xcd_barrier(bar)
#endif
    if (IN(0)) { phase0(L); } SEAM(0);
    if (IN(1)) { phase_rows_u(L); } SEAM(1);
    if (IN(2)) {
        const ArgsP ap = kargs(); unsigned char* ws = ap->ws; const int G = gridDim.x; unsigned char* ob = (unsigned char*)ap->out;
        pg8::Gemm g{(const bf16*)(ob + OUT_U8), (const bf16*)(ws + WS_W8), MROWS, NINB, DM / 2}; pg8::StaticOrder S; S.init(MROWS, NINB, G, (int)blockIdx.x);
        pg8::EpiInB E{ws, ap->g_q, ap->g_k, (LAS float*)(L + XS_OFF)};
        pg8::gemm_phase<pg8::EpiInB, pg8::StaticOrder, PG8_ALIGN, PG8_SP2, PG8_BAL>(L, g, S, E);
    } SEAM(2);
    if (IN(3)) {
        v8t_pass(L); __syncthreads();
        const ArgsP ap = kargs(); unsigned char* ws = ap->ws; const int G = gridDim.x;
        pg8::Gemm g{(const bf16*)(ws + WS_U), (const bf16*)(ws + WS_WIN), MROWS, NINA, DM}; pg8::StaticOrder S; S.init(MROWS, NINA, G, (int)blockIdx.x);
        pg8::EpiInA E{(bf16*)(ws + WS_P)};
        pg8::gemm_phase<pg8::EpiInA, pg8::StaticOrder, PG8_ALIGN, PG8_SP2, PG8_BAL>(L, g, S, E);
    } SEAM(3);
    if (IN(4)) {
        const ArgsP ap = kargs(); unsigned char* ws = ap->ws; const int G = gridDim.x;
        const att::Merge mg{(const bf16*)(ws + WS_SGA), (const bf16*)(ws + WS_GBS), (const bf16*)(ws + WS_P), ap->conv_w, ap->conv_b};
        const signed char* Q = (const signed char*)(ws + WS_Q); bf16* MGo = (bf16*)(ws + WS_U); const signed char* Kb = (const signed char*)(ws + WS_K); const unsigned char* Vb = (const unsigned char*)(ws + WS_V8T);
        int atid = threadIdx.x; asm volatile("" : "+v"(atid));
        for (int ui = blockIdx.x; ui < 3072; ui += G) {
            int kvh, qb, gq, seq, seqrow0;
            if (ui < 1024) { kvh = ui & 7; qb = (ui >> 3) & 31; gq = ui >> 8; seq = SEQS; seqrow0 = MP; }
            else { const int p = ui - 1024, loc = (p >> 3) & 31; kvh = p & 7; gq = loc >> 3; qb = loc & 7; seq = SEQP; seqrow0 = (p >> 8) * SEQP; }
            const int h = kvh * 4 + gq; const size_t row0 = (size_t)seqrow0 + (size_t)qb * 256;
            att::attn_unit(Q + row0 * DM + h * 128, MGo + row0 * DM + h * 128, Kb + (size_t)seqrow0 * KVD + kvh * 128, Vb + (size_t)(kvh * (MROWS / 64) + (seqrow0 >> 6)) * 8192, seq, qb * 256, row0, h, mg, (char*)lds, (char*)lds + ATT_SCR_OFF, atid);
        }
    } SEAM(4);
    if (IN(5)) {
        unsigned char* ws = kargs()->ws; const int G = gridDim.x;
        pg8::Gemm g{(const bf16*)(ws + WS_U), (const bf16*)(ws + WS_WO), MROWS, DM, DM}; pg8::StaticOrder S; S.init(MROWS, DM, G, (int)blockIdx.x);
        pg8::EpiBf16 E{(bf16*)(ws + WS_OUT), DM};
        pg8::gemm_phase<pg8::EpiBf16, pg8::StaticOrder, PG8_ALIGN, PG8_SP2, PG8_BAL>(L, g, S, E);
    } SEAM(5);
    if (IN(6)) { phase_rows_mid(L); } SEAM(6);
    if (IN(7)) {
        if (T8 > 0) {
            const ArgsP ap = kargs(); unsigned char* ws = ap->ws; const int G = gridDim.x;
            pg8::Gemm g{(const bf16*)(ws + WS_U28), (const bf16*)(ws + WS_WUP), MROWS, T8 * 256, DM / 2}; pg8::StaticOrder S; S.init(MROWS, T8 * 256, G, (int)blockIdx.x);
            pg8::EpiUp<true> E{(bf16*)(ws + WS_ACT), (float*)(ws + WS_SB), ap->ffn_conv_w, ap->ffn_conv_b, (const float*)(ws + WS_SU2), (const float*)(ws + WS_SWPU), 0};
            pg8::gemm_phase<pg8::EpiUp<true>, pg8::StaticOrder, PG8_ALIGN, PG8_SP2, PG8_BAL, true>(L, g, S, E);
        }
        if (T8 < NT_UP) {
            const ArgsP ap = kargs(); unsigned char* ws = ap->ws; const int G = gridDim.x;
            pg8::Gemm g{(const bf16*)(ws + WS_U), (const bf16*)(ws + WS_WUP) + (size_t)T8 * 256 * DM, MROWS, (NT_UP - T8) * 256, DM}; pg8::StaticOrder S; S.init(MROWS, (NT_UP - T8) * 256, G, (int)blockIdx.x);
            pg8::EpiUp<false> E{(bf16*)(ws + WS_ACT), (float*)(ws + WS_SB), ap->ffn_conv_w, ap->ffn_conv_b, nullptr, nullptr, T8};
            pg8::gemm_phase<pg8::EpiUp<false>, pg8::StaticOrder, PG8_ALIGN, PG8_SP2, PG8_BAL>(L, g, S, E);
        }
        tail_copy_wdown(L, (MROWS / 256) * (T8 < NT_UP ? NT_UP - T8 : T8));
    } SEAM(7);
    if (IN(8)) { phase_fixup(L); } SEAM(8);
    if (IN(9)) { phase_actq(L); } SEAM(9);
    if (IN(10)) {
        unsigned char* ws = kargs()->ws; const int G = gridDim.x;
        pg8::Gemm g{(const bf16*)(ws + WS_ACT8), (const bf16*)(ws + WS_WDN), MROWS, DM, DFF / 2}; pg8::StaticOrder S; S.init(MROWS, DM, G, (int)blockIdx.x);
        pg8::EpiI8Bf16 E{(bf16*)(ws + WS_Y), DM, (const float*)(ws + WS_SA), (const float*)(ws + WS_SWD)};
        pg8::gemm_phase<pg8::EpiI8Bf16, pg8::StaticOrder, PG8_ALIGN, PG8_SP2, PG8_BAL>(L, g, S, E);
    } SEAM(10);
    if (IN(11)) { phase_rows_final(L); }
#undef IN
#undef SEAM
}

extern "C" void kernel_launch(void* const* d_in, const int* in_sizes, int n_in, void* d_out, int out_size, void* d_ws, size_t ws_size, hipStream_t stream) {
    static int grid = 0;
    if (grid == 0) {
        if (n_in != 20 || in_sizes[0] != MP * DM || in_sizes[1] != MS * DM || out_size != MROWS * DM || ws_size < WS_END) {
            fprintf(stderr, "kernel_launch: shape/workspace mismatch: n_in %d in0 %d in1 %d out %d ws %zu (need %zu); nothing launched\n", n_in, n_in > 0 ? in_sizes[0] : -1, n_in > 1 ? in_sizes[1] : -1, out_size, ws_size, (size_t)WS_END); grid = -1; return; }
        int dev = 0, cus = 0, per_cu = 0;
        if (hipGetDevice(&dev) != hipSuccess || hipDeviceGetAttribute(&cus, hipDeviceAttributeMultiprocessorCount, dev) != hipSuccess) { fprintf(stderr, "kernel_launch: device query failed\n"); grid = -1; return; }
        if (hipFuncSetAttribute((const void*)fwd_kernel, hipFuncAttributeMaxDynamicSharedMemorySize, LDS_BYTES) != hipSuccess) { fprintf(stderr, "kernel_launch: hipFuncSetAttribute failed\n"); grid = -1; return; }
        if (hipOccupancyMaxActiveBlocksPerMultiprocessor(&per_cu, (const void*)fwd_kernel, 512, LDS_BYTES) != hipSuccess || per_cu < 1)
            fprintf(stderr, "kernel_launch: note: occupancy query reports %d workgroups per CU\n", per_cu);
        (void)hipGetLastError();
        grid = cus;
    }
    if (grid < 0) return;
    if (hipMemsetAsync((char*)d_ws + WS_CTL, 0, ZERO_BYTES, stream) != hipSuccess) { fprintf(stderr, "kernel_launch: memset failed\n"); return; }
    Args a{};
    const float** pp = (const float**)&a;
    for (int i = 0; i < 20; ++i) pp[i] = (const float*)d_in[i];
    a.out = (float*)d_out; a.ws = (unsigned char*)d_ws;
#if MK_PER_PHASE
    for (int p = 0; p < NPHASE; ++p) { a.ph_lo = p; a.ph_hi = p + 1; hipLaunchKernelGGL(fwd_kernel, dim3(grid), dim3(512), LDS_BYTES, stream, a); }
#else
    a.ph_lo = 0; a.ph_hi = NPHASE; hipLaunchKernelGGL(fwd_kernel, dim3(grid), dim3(512), LDS_BYTES, stream, a);
#endif
    const hipError_t le = hipPeekAtLastError();
    if (le != hipSuccess) fprintf(stderr, "kernel_launch: launch failed: %s\n", hipGetErrorName(le));
}
```

```cpp
#include <hip/hip_runtime.h>
#include <cstdio>
#include <cstdint>
#include <type_traits>

#ifndef MK_PER_PHASE
#define MK_PER_PHASE 0
#endif

#define GAS __attribute__((address_space(1)))
#define LAS __attribute__((address_space(3)))
typedef unsigned short bf16;
typedef short bf16x8 __attribute__((ext_vector_type(8)));
typedef short s16x4 __attribute__((ext_vector_type(4)));
typedef float f32x4 __attribute__((ext_vector_type(4)));
typedef float f32x16 __attribute__((ext_vector_type(16)));
typedef unsigned u32x4 __attribute__((ext_vector_type(4)));
typedef unsigned u32x2 __attribute__((ext_vector_type(2)));
typedef int i32x4 __attribute__((ext_vector_type(4)));

constexpr int DM = 4096, MP = 16384, MS = 8192, MROWS = MP + MS;
constexpr int SEQP = 2048, SEQS = 8192, NSEQ = 9;
constexpr int NIN = 26624, NUP = 22016, DFF = 11008, KVD = 1024;
constexpr int NINA = 8192, NINB = 18432;
#ifndef UP_T8
#define UP_T8 86
#endif
#ifndef UP_ROT
#define UP_ROT 1
#endif
constexpr int AMX_STRIDE = 8; constexpr float AMX_SAFETY = 1.2f;
constexpr int T8 = UP_T8, NT_UP = NUP / 256;
constexpr float NORM_EPS = 1e-6f;

constexpr size_t MiB = 1u << 20;
constexpr size_t WS_CTL = 0, WS_MOD = 1 * MiB, ZERO_BYTES = 2 * MiB;
constexpr size_t WS_CAMAX = 768 * 1024;
constexpr size_t WS_ROPE = 2 * MiB;
constexpr size_t WS_CAMAX3 = 512 * 1024;
constexpr size_t WS_CAMAX2 = WS_MOD + (size_t)NSEQ * 6 * DM * 4;
constexpr size_t WS_SWP = WS_ROPE + 786432, WS_SU = WS_ROPE + 131072, WS_SU2 = WS_ROPE + 262144, WS_SWPU = WS_ROPE + 393216, WS_SWD = WS_ROPE + 524288, WS_SA = WS_ROPE + 655360;
constexpr size_t WS_W8 = 99 * MiB;
constexpr size_t WS_WIN = 3 * MiB, WS_WO = 211 * MiB, WS_WUP = 243 * MiB, WS_WDN = 415 * MiB;
constexpr size_t WS_ACT8 = 3 * MiB;
constexpr size_t WS_U = 501 * MiB;
constexpr size_t WS_BIG = 693 * MiB;
constexpr size_t WS_Q = WS_BIG, WS_K = WS_BIG + 192 * MiB, WS_V = WS_BIG + 240 * MiB, WS_P = WS_BIG + 288 * MiB, WS_GBS = WS_BIG + 480 * MiB, WS_SGA = WS_BIG + 672 * MiB;
constexpr size_t WS_V8T = WS_K + 24 * MiB;
constexpr size_t WS_OUT = WS_P;
constexpr size_t WS_ACT = WS_BIG, WS_SB = WS_BIG + 516 * MiB, WS_Y = WS_BIG + 600 * MiB, WS_U28 = WS_Y;
constexpr size_t WS_END = WS_BIG + 864 * MiB;
static_assert(T8 == NT_UP, "h1 lives (bf16) where the bf16 copy of u2 would go: all up-projection tiles must be int8");
static_assert(WS_ACT8 + (size_t)MROWS * DFF <= WS_WDN && WS_SA + (size_t)MROWS * 4 <= WS_WIN && WS_CAMAX2 + (size_t)NUP * 4 <= ZERO_BYTES && WS_CAMAX3 + (size_t)DM * 4 <= WS_CAMAX && WS_CAMAX + (size_t)NINB * 4 <= WS_MOD && WS_SWP + (size_t)NINB * 4 <= WS_WIN && WS_SWPU + (size_t)NUP * 4 <= WS_WIN && WS_WIN + (size_t)NINA * DM * 2 <= WS_W8 && WS_W8 + (size_t)NINB * DM <= WS_WO && WS_WO + (size_t)DM * DM * 2 <= WS_WUP && WS_WUP + (size_t)NUP * DM * 2 <= WS_WDN && WS_WDN + (size_t)DM * DFF * 2 <= WS_U, "weights map");
static_assert(WS_U + (size_t)MROWS * DM * 2 <= WS_BIG && WS_ACT + (size_t)MROWS * DFF * 2 <= WS_SB && WS_SB + (size_t)(MROWS / 128) * 4 * NUP * 4 <= WS_Y && WS_Y + (size_t)MROWS * DM * 2 <= WS_END && WS_SGA + (size_t)MROWS * DM * 2 <= WS_END, "act map");
constexpr size_t OUT_U8 = 0;
constexpr int CW_BAR = 4096;

constexpr int LDS_BYTES = 147456;
constexpr int XS_OFF = 135168;
constexpr int ATT_SCR_OFF = 133120;
constexpr int LDSCTL_OFF = 146432;
constexpr int TR_SCR = 16640;

namespace pg8 {
#define PG8_LAS __attribute__((address_space(3)))
typedef unsigned short bf16_t;
constexpr int BM = 256, BK = 64, HALF = 128, HTB = HALF * BK * 2, STAGE_BYTES = 8 * HTB, NXCD = 8, WGM = 8;
__host__ __device__ __forceinline__ int lds_byte(int r, int c) { const int st = (r >> 4) * 2 + (c >> 5), rr = r & 15, cc = c & 31, ob = rr * 64 + cc * 2; return st * 1024 + (ob ^ (((ob >> 9) & 1) << 5)); }
__host__ __device__ __forceinline__ void stage_rc(int b, int& R, int& C) { const int st = b / 1024, sb = b % 1024, swz = sb ^ (((sb >> 9) & 1) << 5); R = (st >> 1) * 16 + swz / 64; C = (st & 1) * 32 + (swz % 64) / 2; }
__host__ __device__ __forceinline__ int perm32(int rho) { const int n = rho >> 4, i = rho & 15; return 8 * (i >> 2) + 4 * n + (i & 3); }
struct Unit { int pm, pn; };
struct Gemm { const bf16_t* A; const bf16_t* Bt; int M, N, K; };
struct StaticOrder {
    int nM, nN, nwg, G, c;
    __host__ __device__ void init(int M, int N, int G_, int c_) { nM = M / BM; nN = N / BM; nwg = nM * nN; G = G_; c = c_; }
    __host__ __device__ bool next(int i, Unit& u) const {
        const long L = (long)i * G + c; if (L >= nwg) return false;
        int wgid = (int)L; { const int q = nwg / NXCD, r = nwg % NXCD, xcd = wgid % NXCD, off = wgid / NXCD; wgid = (xcd < r ? xcd * (q + 1) : r * (q + 1) + (xcd - r) * q) + off; }
        const int nig = WGM * nN, gid = wgid / nig, fm = gid * WGM, gsz = (nM - fm) < WGM ? (nM - fm) : WGM;
        u.pm = fm + ((wgid % nig) % gsz); u.pn = (wgid % nig) / gsz; return true;
    }
    __device__ __forceinline__ void a_ready(const Unit&) const {}
    __device__ __forceinline__ void done(const Unit&) const {}
};
__device__ __forceinline__ unsigned cvt_pk_bf16(float lo, float hi) { unsigned r; asm volatile("v_cvt_pk_bf16_f32 %0, %1, %2" : "=v"(r) : "v"(lo), "v"(hi)); return r; }
__device__ __forceinline__ float sigmoidf_(float x) { return __builtin_amdgcn_rcpf(1.0f + __builtin_amdgcn_exp2f(-1.4426950408889634f * x)); }
__device__ __forceinline__ f32x4 sig4(f32x4 v) { return (f32x4){sigmoidf_(v[0]), sigmoidf_(v[1]), sigmoidf_(v[2]), sigmoidf_(v[3])}; }
__device__ __forceinline__ u32x4 pack8(f32x4 v0, f32x4 v1) { u32x4 w; w.x = cvt_pk_bf16(v0[0], v0[1]); w.y = cvt_pk_bf16(v0[2], v0[3]); w.z = cvt_pk_bf16(v1[0], v1[1]); w.w = cvt_pk_bf16(v1[2], v1[3]); return w; }

__device__ __forceinline__ f32x4 mma_(bf16x8 b, bf16x8 a, f32x4 c) { return __builtin_amdgcn_mfma_f32_16x16x32_bf16(b, a, c, 0, 0, 0); }
__device__ __forceinline__ i32x4 mma_(bf16x8 b, bf16x8 a, i32x4 c) { return __builtin_amdgcn_mfma_i32_16x16x64_i8(__builtin_bit_cast(i32x4, b), __builtin_bit_cast(i32x4, a), c, 0, 0, 0); }
__device__ __forceinline__ f32x4 cvtf(i32x4 v) { return (f32x4){(float)v[0], (float)v[1], (float)v[2], (float)v[3]}; }
struct EpiI8Bf16 {
    static constexpr bool PERM = true, AFTER_DRAIN = false, ROWPERM = false, I8 = true; static constexpr int NS_MIN = 16;
    bf16_t* O; int ldc; const float* su; const float* sw;
    __device__ __forceinline__ void operator()(const i32x4 (&acc)[2][2][4][2], const Unit& u, int wr, int wc, int fr, int fq) const {
        const int row0 = u.pm * BM + wr * 64 + fr, col0 = u.pn * BM + wc * 32 + 8 * fq;
        f32x4 cs_[2][2];
#pragma unroll
        for (int bj = 0; bj < 2; ++bj)
#pragma unroll
            for (int n = 0; n < 2; ++n) cs_[bj][n] = *(const f32x4*)(sw + col0 + bj * HALF + 4 * n);
#pragma unroll
        for (int ai = 0; ai < 2; ++ai)
#pragma unroll
            for (int m = 0; m < 4; ++m) { const int row = row0 + ai * HALF + m * 16; const float rs = su[row]; bf16_t* rowp = O + (size_t)row * ldc + col0;
#pragma unroll
                for (int bj = 0; bj < 2; ++bj) *(u32x4*)(rowp + bj * HALF) = pack8(cvtf(acc[ai][bj][m][0]) * cs_[bj][0] * rs, cvtf(acc[ai][bj][m][1]) * cs_[bj][1] * rs); }
    }
};
struct EpiBf16 {
    static constexpr bool PERM = true, AFTER_DRAIN = false, ROWPERM = false, I8 = false; static constexpr int NS_MIN = 16;
    bf16_t* O; int ldc;
    __device__ __forceinline__ void operator()(const f32x4 (&acc)[2][2][4][2], const Unit& u, int wr, int wc, int fr, int fq) const {
        const int row0 = u.pm * BM + wr * 64 + fr, col0 = u.pn * BM + wc * 32 + 8 * fq;
#pragma unroll
        for (int ai = 0; ai < 2; ++ai)
#pragma unroll
            for (int m = 0; m < 4; ++m) { bf16_t* rowp = O + (size_t)(row0 + ai * HALF + m * 16) * ldc + col0;
#pragma unroll
                for (int bj = 0; bj < 2; ++bj) *(u32x4*)(rowp + bj * HALF) = pack8(acc[ai][bj][m][0], acc[ai][bj][m][1]); }
    }
};
__device__ __forceinline__ unsigned cvt4_fp8_(f32x4 v) { int w = __builtin_amdgcn_cvt_pk_fp8_f32(v[0], v[1], 0, false); return (unsigned)__builtin_amdgcn_cvt_pk_fp8_f32(v[2], v[3], w, true); }
struct EpiInB {
    static constexpr bool PERM = true, AFTER_DRAIN = false, ROWPERM = false, I8 = true; static constexpr int NS_MIN = 16;
    unsigned char* ws; const float *gq, *gk; PG8_LAS float* XS;
    __device__ __forceinline__ void operator()(const i32x4 (&acc)[2][2][4][2], const Unit& u, int wr, int wc, int fr_, int fq_) const {
        bf16_t* const Q = (bf16_t*)(ws + WS_Q); bf16_t* const Kb = (bf16_t*)(ws + WS_K); bf16_t* const Vb = (bf16_t*)(ws + WS_V); bf16_t* const SGA = (bf16_t*)(ws + WS_SGA); bf16_t* const GBS = (bf16_t*)(ws + WS_GBS);
        const float* const rope = (const float*)(ws + WS_ROPE); const float* const su = (const float*)(ws + WS_SU); const float* const sw = (const float*)(ws + WS_SWP);
        int ln = fq_ * 16 + fr_; asm volatile("" : "+v"(ln)); const int fr = ln & 15, fq = ln >> 4;
        const int row0 = u.pm * BM + wr * 64 + fr, cw = wc * 32 + 8 * fq, pn = u.pn;
        f32x4 cs_[2][2];
#pragma unroll
        for (int bj = 0; bj < 2; ++bj)
#pragma unroll
            for (int n = 0; n < 2; ++n) cs_[bj][n] = *(const f32x4*)(sw + pn * 256 + bj * HALF + cw + 4 * n);
        if (pn < 20) {
            const bool isq = pn < 16; signed char* base = isq ? (signed char*)Q + pn * 256 : (signed char*)Kb + (pn - 16) * 256; const int ldc = isq ? DM : KVD; const float* g = isq ? gq : gk;
            const int half = wc >> 1, i0 = 16 * (wc & 1) + 4 * fq, d1 = 64 * half + i0;
            const f32x4 g1 = *(const f32x4*)(g + d1), g2 = *(const f32x4*)(g + d1 + 32);
#pragma unroll
            for (int ai = 0; ai < 2; ++ai)
#pragma unroll
                for (int m = 0; m < 4; ++m) { const float rs = su[row0 + ai * HALF + m * 16];
#pragma unroll
                    for (int bj = 0; bj < 2; ++bj) { const f32x4 a = cvtf(acc[ai][bj][m][0]) * cs_[bj][0] * rs, b = cvtf(acc[ai][bj][m][1]) * cs_[bj][1] * rs;
                        float sq = (a[0] * a[0] + a[1] * a[1]) + (a[2] * a[2] + a[3] * a[3]) + (b[0] * b[0] + b[1] * b[1]) + (b[2] * b[2] + b[3] * b[3]);
                        sq += __shfl_xor(sq, 16); sq += __shfl_xor(sq, 32);
                        if (fq == 0) XS[(ai * HALF + wr * 64 + m * 16 + fr) * 8 + bj * 4 + wc] = sq; } }
            asm volatile("s_waitcnt lgkmcnt(0)" ::: "memory"); __builtin_amdgcn_s_barrier(); asm volatile("" ::: "memory");
#pragma unroll
            for (int ai = 0; ai < 2; ++ai)
#pragma unroll
                for (int m = 0; m < 4; ++m) { const int rit = ai * HALF + wr * 64 + m * 16 + fr, row = u.pm * BM + rit; const float rs = su[row];
                    const int t = row < MP ? (row & (SEQP - 1)) : (row - MP), pos = half ? (t & 63) : (t >> 6);
                    const f32x4 cs = *(const f32x4*)(rope + pos * 32 + i0), sn = *(const f32x4*)(rope + 4096 + pos * 32 + i0);
#pragma unroll
                    for (int bj = 0; bj < 2; ++bj) { const f32x4 ps = *(const PG8_LAS f32x4*)(XS + rit * 8 + bj * 4);
                        const float rstd = rs / sqrtf(((ps[0] + ps[1]) + (ps[2] + ps[3])) * (1.0f / 128.0f) + NORM_EPS);
                        const f32x4 y1 = cvtf(acc[ai][bj][m][0]) * cs_[bj][0] * rstd * g1, y2 = cvtf(acc[ai][bj][m][1]) * cs_[bj][1] * rstd * g2;
                        const f32x4 o1 = y1 * cs - y2 * sn, o2 = y2 * cs + y1 * sn;
                        signed char* op = base + (size_t)row * ldc + bj * HALF + d1;
                        *(unsigned*)op = cvt4_fp8_(o1); *(unsigned*)(op + 32) = cvt4_fp8_(o2); } }
        } else if (pn < 40) {
            const bool sg = pn >= 24; bf16_t* base = sg ? SGA + (pn - 24) * 256 : Vb + (pn - 20) * 256; const int ldc = sg ? DM : KVD;
#pragma unroll
            for (int ai = 0; ai < 2; ++ai)
#pragma unroll
                for (int m = 0; m < 4; ++m) { const int row = row0 + ai * HALF + m * 16; const float rs = su[row]; bf16_t* rowp = base + (size_t)row * ldc + cw;
#pragma unroll
                    for (int bj = 0; bj < 2; ++bj) { f32x4 v0 = cvtf(acc[ai][bj][m][0]) * cs_[bj][0] * rs, v1 = cvtf(acc[ai][bj][m][1]) * cs_[bj][1] * rs; if (sg) { v0 = sig4(v0); v1 = sig4(v1); } *(u32x4*)(rowp + bj * HALF) = pack8(v0, v1); } }
        } else {
            bf16_t* base = GBS + (pn - 40) * 128;
#pragma unroll
            for (int ai = 0; ai < 2; ++ai)
#pragma unroll
                for (int m = 0; m < 4; ++m) { const int row = row0 + ai * HALF + m * 16; const float rs = su[row];
                    const f32x4 v0 = cvtf(acc[ai][0][m][0]) * cs_[0][0] * rs, v1 = cvtf(acc[ai][0][m][1]) * cs_[0][1] * rs;
                    const f32x4 g0 = sig4(cvtf(acc[ai][1][m][0]) * cs_[1][0] * rs), g1 = sig4(cvtf(acc[ai][1][m][1]) * cs_[1][1] * rs);
                    *(u32x4*)(base + (size_t)row * DM + cw) = pack8(v0 * g0, v1 * g1); }
        }
    }
};
struct EpiInA {
    static constexpr bool PERM = true, AFTER_DRAIN = false, ROWPERM = false, I8 = false; static constexpr int NS_MIN = 8;
    bf16_t* P;
    __device__ __forceinline__ void operator()(const f32x4 (&acc)[2][2][4][2], const Unit& u, int wr, int wc, int fr, int fq) const {
        const int row0 = u.pm * BM + wr * 64 + fr, cw = wc * 32 + 8 * fq, pn = u.pn;
        bf16_t* base = P + pn * 128;
#pragma unroll
        for (int ai = 0; ai < 2; ++ai)
#pragma unroll
            for (int m = 0; m < 4; ++m) { bf16_t* rowp = base + (size_t)(row0 + ai * HALF + m * 16) * DM + cw;
                *(u32x4*)rowp = pack8(acc[ai][0][m][0] * acc[ai][1][m][0], acc[ai][0][m][1] * acc[ai][1][m][1]); }
    }
};

__device__ __forceinline__ f32x4 dpp_prev(f32x4 v) { f32x4 r;
#pragma unroll
    for (int e = 0; e < 4; ++e) { const float x = v[e]; r[e] = __int_as_float(__builtin_amdgcn_update_dpp(0, __float_as_int(x), 0x111, 0xf, 0xf, true)); }
    return r; }
__device__ __forceinline__ f32x4 dpp_next(f32x4 v) { f32x4 r;
#pragma unroll
    for (int e = 0; e < 4; ++e) { const float x = v[e]; r[e] = __int_as_float(__builtin_amdgcn_update_dpp(0, __float_as_int(x), 0x101, 0xf, 0xf, true)); }
    return r; }
template <bool I8_> struct EpiUp {
    static constexpr bool PERM = true, AFTER_DRAIN = false, ROWPERM = true, I8 = I8_; static constexpr int NS_MIN = 8;
    typedef typename std::conditional<I8_, i32x4, f32x4>::type acc_t;
    bf16_t* ACT; float* SB; const float* cw; const float* cb; const float* su; const float* sw; int pn0;
    static __device__ __forceinline__ f32x4 asf(f32x4 v) { return v; }
    static __device__ __forceinline__ f32x4 toa(f32x4 v) { return v; }
    __device__ __forceinline__ void operator()(acc_t (&accr)[2][2][4][2], const Unit& u, int wr, int wc, int fr_, int fq_) const {
        int ln = fq_ * 16 + fr_; asm volatile("" : "+v"(ln)); const int fr = ln & 15, fq = ln >> 4;
        const int pn = u.pn + pn0, cw8 = wc * 32 + 8 * fq, f0 = pn * 128 + cw8;
        const int strip = u.pm * 2 + wr; const size_t grow0 = (size_t)u.pm * BM + wr * 128 + fr * 8;
        float* sb = SB + (size_t)strip * 4 * NUP + (size_t)pn * 256 + cw8;
        f32x4 acc[2][2][4][2];
        if constexpr (I8_) {
            const f32x4 rsa = *(const f32x4*)(su + grow0), rsb = *(const f32x4*)(su + grow0 + 4);
#pragma unroll
            for (int j = 0; j < 8; ++j)
#pragma unroll
                for (int bj = 0; bj < 2; ++bj)
#pragma unroll
                    for (int n = 0; n < 2; ++n) { f32x4 t = cvtf(accr[j >> 2][bj][j & 3][n]) * (j < 4 ? rsa[j & 3] : rsb[j & 3]); asm volatile("" : "+v"(t)); acc[j >> 2][bj][j & 3][n] = t; }
        } else {
#pragma unroll
            for (int a = 0; a < 2; ++a)
#pragma unroll
                for (int b = 0; b < 2; ++b)
#pragma unroll
                    for (int m = 0; m < 4; ++m)
#pragma unroll
                        for (int n = 0; n < 2; ++n) acc[a][b][m][n] = accr[a][b][m][n];
        }
        f32x4 wv[2][2][4], csc[2][2];
#pragma unroll
        for (int bj = 0; bj < 2; ++bj)
#pragma unroll
            for (int n = 0; n < 2; ++n) { const int ci = bj * DFF + f0 + 4 * n;
                wv[bj][n][0] = *(const f32x4*)(cw + ci); wv[bj][n][1] = *(const f32x4*)(cw + NUP + ci); wv[bj][n][2] = *(const f32x4*)(cw + 2 * NUP + ci); wv[bj][n][3] = *(const f32x4*)(cb + ci);
                csc[bj][n] = I8_ ? *(const f32x4*)(sw + pn * 256 + bj * HALF + cw8 + 4 * n) : (f32x4){1.f, 1.f, 1.f, 1.f}; }
#pragma unroll
        for (int bj = 0; bj < 2; ++bj)
#pragma unroll
            for (int n = 0; n < 2; ++n) {
                if (fr == 0) *(f32x4*)(sb + bj * 128 + 4 * n) = acc[0][bj][0][n] * csc[bj][n];
                if (fr == 15) *(f32x4*)(sb + NUP + bj * 128 + 4 * n) = acc[1][bj][3][n] * csc[bj][n];
                const f32x4 w0 = wv[bj][n][0] * csc[bj][n], w1 = wv[bj][n][1] * csc[bj][n], w2 = wv[bj][n][2] * csc[bj][n], bb = wv[bj][n][3];
                f32x4 p = dpp_prev(acc[1][bj][3][n]); const f32x4 nx = dpp_next(acc[0][bj][0][n]);
#pragma unroll
                for (int j = 0; j < 8; ++j) { const f32x4 cur = acc[j >> 2][bj][j & 3][n]; const f32x4 nn = j < 7 ? acc[(j + 1) >> 2][bj][(j + 1) & 3][n] : nx;
                    acc[j >> 2][bj][j & 3][n] = w0 * p + (w1 * cur + (w2 * nn + bb)); p = cur; }
                if (fr == 0) *(f32x4*)(sb + 2 * NUP + bj * 128 + 4 * n) = acc[0][bj][0][n];
                if (fr == 15) *(f32x4*)(sb + 3 * NUP + bj * 128 + 4 * n) = acc[1][bj][3][n]; }
#pragma unroll
        for (int j = 0; j < 8; ++j) {
            f32x4 a0 = asf(acc[j >> 2][0][j & 3][0]), a1 = asf(acc[j >> 2][0][j & 3][1]); const f32x4 b0 = asf(acc[j >> 2][1][j & 3][0]), b1 = asf(acc[j >> 2][1][j & 3][1]);
            a0 = a0 * sig4(a0) * b0; a1 = a1 * sig4(a1) * b1;
            const bool skip = (j == 0 && fr == 0) || (j == 7 && fr == 15);
            if (!skip) __builtin_nontemporal_store(pack8(a0, a1), (u32x4*)(ACT + (grow0 + j) * DFF + f0));
            asm volatile("" ::: "memory"); __builtin_amdgcn_sched_barrier(0); }
    }
};

template <class Epi, class Sched, bool ALIGN_EPI = false, bool SP2 = false, bool BAL = false, bool REL = false>
__device__ __forceinline__ void gemm_phase(PG8_LAS unsigned char* lds, const Gemm g, const Sched& S, const Epi& E) {
    int tid_ = threadIdx.x; asm volatile("" : "+v"(tid_));
    const int tid = tid_, wid = __builtin_amdgcn_readfirstlane(tid >> 6), lane = tid & 63, wr = wid >> 2, wc = wid & 3, fr = lane & 15, fq = lane >> 4;
    const int K = g.K, nt = K / BK;
    unsigned voffA, voffB;
    { int R, C; stage_rc(tid * 16, R, C); const int Rb = Epi::PERM ? ((R & ~31) + perm32(R & 31)) : R;
        const int Ra = Epi::ROWPERM ? (128 * (R >> 6) + 8 * (R & 15) + ((R >> 4) & 3)) : R;
        voffA = (unsigned)(Ra * K + C) * 2u; voffB = (unsigned)(Rb * K + C) * 2u; }
    const size_t pstepB = (size_t)64 * K * 2, pstepA = Epi::ROWPERM ? (size_t)128 * K * 2 : pstepB;
    const size_t kstep = (size_t)(BK * 2);
    const size_t hstep = (size_t)HALF * K * 2;
    const size_t hstepA = Epi::ROWPERM ? (size_t)4 * K * 2 : hstep;
    const size_t tstep = 2 * hstep;
    const unsigned ldsw = (unsigned)wid * 1024u;
    const int aoff = lds_byte(wr * 64 + fr, fq * 8), boff = lds_byte(wc * 32 + fr, fq * 8);
#define PG8_SA(b, h) (((b) * 2 + (h)) * HTB)
#define PG8_SB(b, h) ((4 + (b) * 2 + (h)) * HTB)
#define PG8_STAGE(bufoff, gbase, voff) do { _Pragma("unroll") for (int _i = 0; _i < 2; ++_i) \
        __builtin_amdgcn_global_load_lds((const unsigned*)((const char*)(gbase) + (size_t)_i * p##voff + (voff)), (PG8_LAS unsigned*)(lds + (bufoff) + ldsw + _i * 8192), 16, 0, 0); } while (0)
#define pvoffA pstepA
#define pvoffB pstepB
#define PG8_LDA(dst, b, h) do { _Pragma("unroll") for (int m = 0; m < 4; ++m) _Pragma("unroll") for (int k = 0; k < 2; ++k) dst[m][k] = *(const PG8_LAS bf16x8*)(lds + PG8_SA(b, h) + aoff + m * 2048 + k * 1024); } while (0)
#define PG8_LDB(dst, b, h) do { _Pragma("unroll") for (int n = 0; n < 2; ++n) _Pragma("unroll") for (int k = 0; k < 2; ++k) dst[n][k] = *(const PG8_LAS bf16x8*)(lds + PG8_SB(b, h) + boff + n * 2048 + k * 1024); } while (0)
#define PG8_MMA(ai, bj, At, Bt) do { __builtin_amdgcn_s_setprio(1); _Pragma("unroll") for (int m = 0; m < 4; ++m) _Pragma("unroll") for (int n = 0; n < 2; ++n) _Pragma("unroll") for (int k = 0; k < 2; ++k) \
        acc[ai][bj][m][n] = mma_(Bt[n][k], At[m][k], acc[ai][bj][m][n]); __builtin_amdgcn_s_setprio(0); } while (0)
#define PG8_WAIT_V(n) asm volatile("s_waitcnt vmcnt(" #n ")" ::: "memory")
#define PG8_WAIT_VN(N) asm volatile("s_waitcnt vmcnt(%0)" :: "i"(N) : "memory")
#define PG8_WAIT_L(n) asm volatile("s_waitcnt lgkmcnt(" #n ")" ::: "memory")
#define PG8_BAR __builtin_amdgcn_s_barrier()
#define PG8_SCHED __builtin_amdgcn_sched_barrier(0)
    Unit cur, nxt; int ui = 0;
    if (!S.next(0, cur)) return;
    typedef typename std::conditional<Epi::I8, i32x4, f32x4>::type acc_t;
    acc_t acc[2][2][4][2];
#pragma unroll
    for (int a = 0; a < 2; ++a)
#pragma unroll
        for (int b = 0; b < 2; ++b)
#pragma unroll
            for (int m = 0; m < 4; ++m)
#pragma unroll
                for (int n = 0; n < 2; ++n) acc[a][b][m][n] = (acc_t){0, 0, 0, 0};
    bf16x8 At[4][2], B0[2][2], B1[2][2];
    const char* cA = (const char*)g.A + (size_t)cur.pm * tstep; const char* cB = (const char*)g.Bt + (size_t)cur.pn * tstep;
    S.a_ready(cur);
    if constexpr (SP2 && BAL && REL) {
        PG8_STAGE(PG8_SB(0, 0), cB, voffB); PG8_STAGE(PG8_SB(0, 1), cB + hstep, voffB); PG8_STAGE(PG8_SA(0, 0), cA, voffA); PG8_STAGE(PG8_SA(0, 1), cA + hstepA, voffA);
        PG8_STAGE(PG8_SB(1, 0), cB + kstep, voffB); PG8_STAGE(PG8_SB(1, 1), cB + hstep + kstep, voffB); PG8_STAGE(PG8_SA(1, 0), cA + kstep, voffA); PG8_STAGE(PG8_SA(1, 1), cA + kstep + hstepA, voffA);
        if (wr == 1) PG8_BAR;
        PG8_WAIT_V(0); PG8_BAR;
        PG8_BAR;
    } else if constexpr (SP2 && BAL) {
        PG8_STAGE(PG8_SB(0, 0), cB, voffB); PG8_STAGE(PG8_SB(0, 1), cB + hstep, voffB); PG8_STAGE(PG8_SA(0, 0), cA, voffA); PG8_STAGE(PG8_SA(0, 1), cA + hstepA, voffA);
        if (wr == 1) PG8_BAR;
        PG8_WAIT_V(2); PG8_BAR;
        PG8_STAGE(PG8_SB(1, 0), cB + kstep, voffB); PG8_STAGE(PG8_SB(1, 1), cB + hstep + kstep, voffB);
        PG8_BAR;
    } else if constexpr (SP2) {
        PG8_STAGE(PG8_SB(0, 0), cB, voffB); PG8_STAGE(PG8_SB(0, 1), cB + hstep, voffB); PG8_STAGE(PG8_SA(0, 0), cA, voffA); PG8_STAGE(PG8_SA(0, 1), cA + hstepA, voffA);
        if (wr == 1) PG8_BAR;
        PG8_WAIT_V(2); PG8_BAR;
        PG8_STAGE(PG8_SB(1, 0), cB + kstep, voffB); PG8_STAGE(PG8_SA(1, 0), cA + kstep, voffA); PG8_STAGE(PG8_SB(1, 1), cB + hstep + kstep, voffB);
        PG8_WAIT_V(6); PG8_BAR;
    } else {
        PG8_STAGE(PG8_SB(0, 0), cB, voffB); PG8_STAGE(PG8_SA(0, 0), cA, voffA); PG8_STAGE(PG8_SB(0, 1), cB + hstep, voffB); PG8_STAGE(PG8_SA(0, 1), cA + hstepA, voffA);
        if (wr == 1) PG8_BAR;
        PG8_WAIT_V(4); PG8_BAR;
        PG8_STAGE(PG8_SB(1, 0), cB + kstep, voffB); PG8_STAGE(PG8_SA(1, 0), cA + kstep, voffA); PG8_STAGE(PG8_SB(1, 1), cB + hstep + kstep, voffB);
        PG8_WAIT_V(6); PG8_BAR;
    }
    for (;;) {
        const bool has_next = S.next(ui + 1, nxt);
        const char* nA = has_next ? (const char*)g.A + (size_t)nxt.pm * tstep : cA; const char* nB = has_next ? (const char*)g.Bt + (size_t)nxt.pn * tstep : cB;
        for (int t = 0; t < nt; t += 2) {
            const bool last = (t == nt - 2);
            const char* a1 = cA + (size_t)(t + 1) * kstep;
            const char* a2 = last ? nA : cA + (size_t)(t + 2) * kstep; const char* b2 = last ? nB : cB + (size_t)(t + 2) * kstep;
            const char* a3 = a2 + kstep; const char* b3 = b2 + kstep;
            if (last && has_next) S.a_ready(nxt);
            if constexpr (SP2 && BAL) {
            constexpr int NS = Epi::NS_MIN; const bool first = REL && (t == 0);
            PG8_LDB(B0, 0, 0); PG8_LDB(B1, 0, 1); PG8_SCHED; PG8_LDA(At, 0, 0); if (!REL || !first) { PG8_STAGE(PG8_SA(1, 0), a1, voffA); PG8_STAGE(PG8_SA(1, 1), a1 + hstepA, voffA); }
            if (REL && first) PG8_WAIT_VN(8 + NS); else PG8_WAIT_V(8);
            PG8_WAIT_L(0); PG8_BAR; PG8_MMA(0, 0, At, B0); PG8_MMA(0, 1, At, B1); PG8_BAR; PG8_SCHED;
            PG8_LDA(At, 0, 1); PG8_STAGE(PG8_SB(0, 0), b2, voffB); PG8_STAGE(PG8_SB(0, 1), b2 + hstep, voffB);
            if (REL && first) PG8_WAIT_VN(6 + NS); else PG8_WAIT_V(6);
            PG8_WAIT_L(0); PG8_BAR; PG8_MMA(1, 0, At, B0); PG8_MMA(1, 1, At, B1); PG8_BAR; PG8_SCHED;
            PG8_LDB(B0, 1, 0); PG8_LDB(B1, 1, 1); PG8_SCHED; PG8_LDA(At, 1, 0); PG8_STAGE(PG8_SA(0, 0), a2, voffA); PG8_STAGE(PG8_SA(0, 1), a2 + hstepA, voffA);
            if (REL && first) PG8_WAIT_VN(8 + NS); else PG8_WAIT_V(8);
            PG8_WAIT_L(0); PG8_BAR; PG8_MMA(0, 0, At, B0); PG8_MMA(0, 1, At, B1); PG8_BAR; PG8_SCHED;
            PG8_LDA(At, 1, 1); PG8_STAGE(PG8_SB(1, 0), b3, voffB); PG8_STAGE(PG8_SB(1, 1), b3 + hstep, voffB);
            PG8_WAIT_V(6); PG8_WAIT_L(0); PG8_BAR; PG8_MMA(1, 0, At, B0); PG8_MMA(1, 1, At, B1); PG8_BAR; PG8_SCHED;
            } else if constexpr (SP2) {
            PG8_LDB(B0, 0, 0); PG8_LDB(B1, 0, 1); PG8_SCHED; PG8_LDA(At, 0, 0); PG8_STAGE(PG8_SA(1, 1), a1 + hstepA, voffA);
            PG8_WAIT_V(8); PG8_WAIT_L(0); PG8_BAR; PG8_MMA(0, 0, At, B0); PG8_MMA(0, 1, At, B1); PG8_BAR; PG8_SCHED;
            PG8_LDA(At, 0, 1); PG8_STAGE(PG8_SB(0, 0), b2, voffB); PG8_STAGE(PG8_SB(0, 1), b2 + hstep, voffB); PG8_STAGE(PG8_SA(0, 0), a2, voffA);
            PG8_WAIT_V(8); PG8_WAIT_L(0); PG8_BAR; PG8_MMA(1, 0, At, B0); PG8_MMA(1, 1, At, B1); PG8_BAR; PG8_SCHED;
            PG8_LDB(B0, 1, 0); PG8_LDB(B1, 1, 1); PG8_SCHED; PG8_LDA(At, 1, 0); PG8_STAGE(PG8_SA(0, 1), a2 + hstepA, voffA);
            PG8_WAIT_V(8); PG8_WAIT_L(0); PG8_BAR; PG8_MMA(0, 0, At, B0); PG8_MMA(0, 1, At, B1); PG8_BAR; PG8_SCHED;
            PG8_LDA(At, 1, 1); PG8_STAGE(PG8_SB(1, 0), b3, voffB); PG8_STAGE(PG8_SB(1, 1), b3 + hstep, voffB); PG8_STAGE(PG8_SA(1, 0), a3, voffA);
            PG8_WAIT_V(8); PG8_WAIT_L(0); PG8_BAR; PG8_MMA(1, 0, At, B0); PG8_MMA(1, 1, At, B1); PG8_BAR; PG8_SCHED;
            } else {
            PG8_LDB(B0, 0, 0); PG8_SCHED; PG8_LDA(At, 0, 0); PG8_STAGE(PG8_SA(1, 1), a1 + hstepA, voffA);
            PG8_WAIT_L(8); PG8_BAR; PG8_WAIT_L(0); PG8_MMA(0, 0, At, B0); PG8_BAR; PG8_SCHED;
            PG8_LDB(B1, 0, 1); PG8_STAGE(PG8_SB(0, 0), b2, voffB);
            PG8_BAR; PG8_WAIT_L(0); PG8_MMA(0, 1, At, B1); PG8_BAR;
            PG8_LDA(At, 0, 1); PG8_STAGE(PG8_SA(0, 0), a2, voffA);
            PG8_BAR; PG8_WAIT_L(0); PG8_MMA(1, 0, At, B0); PG8_BAR; PG8_SCHED;
            PG8_STAGE(PG8_SB(0, 1), b2 + hstep, voffB);
            PG8_WAIT_V(6); PG8_BAR; PG8_MMA(1, 1, At, B1); PG8_BAR;
            PG8_LDB(B0, 1, 0); PG8_SCHED; PG8_LDA(At, 1, 0); PG8_STAGE(PG8_SA(0, 1), a2 + hstepA, voffA);
            PG8_WAIT_L(8); PG8_BAR; PG8_WAIT_L(0); PG8_MMA(0, 0, At, B0); PG8_BAR; PG8_SCHED;
            PG8_LDB(B1, 1, 1); PG8_STAGE(PG8_SB(1, 0), b3, voffB);
            PG8_BAR; PG8_WAIT_L(0); PG8_MMA(0, 1, At, B1); PG8_BAR;
            PG8_LDA(At, 1, 1); PG8_STAGE(PG8_SA(1, 0), a3, voffA);
            PG8_BAR; PG8_WAIT_L(0); PG8_MMA(1, 0, At, B0); PG8_BAR; PG8_SCHED;
            PG8_STAGE(PG8_SB(1, 1), b3 + hstep, voffB);
            PG8_WAIT_V(6); PG8_BAR; PG8_MMA(1, 1, At, B1); PG8_BAR;
            }
        }
        if constexpr (SP2 && BAL && REL) { if (has_next) { PG8_STAGE(PG8_SA(1, 0), nA + kstep, voffA); PG8_STAGE(PG8_SA(1, 1), nA + kstep + hstepA, voffA); } }
        if constexpr (ALIGN_EPI) { if (wr == 0) PG8_BAR; }
        if constexpr (!Epi::AFTER_DRAIN) { E(acc, cur, wr, wc, fr, fq); S.done(cur); }
        if (!has_next) break;
#pragma unroll
        for (int a = 0; a < 2; ++a)
#pragma unroll
            for (int b = 0; b < 2; ++b)
#pragma unroll
                for (int m = 0; m < 4; ++m)
#pragma unroll
                    for (int n = 0; n < 2; ++n) acc[a][b][m][n] = (acc_t){0, 0, 0, 0};
        cur = nxt; cA = nA; cB = nB; ++ui;
        if constexpr (ALIGN_EPI) { if (wr == 1) PG8_BAR; }
    }
    PG8_WAIT_V(0);
    if constexpr (!ALIGN_EPI) { if (wr == 0) PG8_BAR; }
    PG8_BAR;
#undef PG8_SA
#undef PG8_SB
#undef PG8_STAGE
#undef pvoffA
#undef pvoffB
#undef PG8_LDA
#undef PG8_LDB
#undef PG8_MMA
#undef PG8_WAIT_V
#undef PG8_WAIT_VN
#undef PG8_WAIT_L
#undef PG8_BAR
#undef PG8_SCHED
}
}
#define PG8_SP2 true
#define PG8_ALIGN true
#define PG8_BAL true

namespace att {
constexpr int D = 128, NW = 8, QBLK = 32, KVBLK = 64;
constexpr float SCALE = 0.088388347648318440f;
constexpr float THR = 5.f;
constexpr int LDQ = DM, LDK = KVD;
constexpr size_t SHM_V = KVBLK * D * 2, SHM_K = KVBLK * D * 2, SHM_K8 = KVBLK * D;
#define KSWZ(row, colB) ((row) * 256 + ((colB) ^ (((row) & 7) << 4)))
#define SBAR() __builtin_amdgcn_sched_barrier(0)
__device__ __forceinline__ int crow(int r, int hi) { return (r & 3) + 8 * (r >> 2) + 4 * hi; }
__device__ __forceinline__ unsigned cvtpk(float lo, float hi) { unsigned r; asm volatile("v_cvt_pk_bf16_f32 %0, %1, %2" : "=v"(r) : "v"(lo), "v"(hi)); return r; }
__device__ __forceinline__ void partialSM(f32x16& p0, f32x16& p1, float& m_reg, float& mn, float& alpha) {
  constexpr float C = SCALE * 1.4426950408889634f, THRQ = THR / SCALE;
  float pmax = p0[0];
#pragma unroll
  for (int r = 1; r < 16; ++r) pmax = fmaxf(pmax, p0[r]);
#pragma unroll
  for (int r = 0; r < 16; ++r) pmax = fmaxf(pmax, p1[r]);
  { auto rr = __builtin_amdgcn_permlane32_swap(__float_as_uint(pmax), __float_as_uint(pmax), false, false);
    pmax = fmaxf(__uint_as_float(rr[0]), __uint_as_float(rr[1])); }
  if (__builtin_expect(__all(pmax - m_reg <= THRQ), 1)) { mn = m_reg; alpha = 1.f; }
  else { mn = fmaxf(m_reg, pmax); alpha = __builtin_amdgcn_exp2f((m_reg - mn) * C); m_reg = mn; }
  float mnC = -mn * C;
#pragma unroll
  for (int r = 0; r < 16; ++r) p0[r] = fmaf(p0[r], C, mnC);
#pragma unroll
  for (int r = 0; r < 16; ++r) p1[r] = fmaf(p1[r], C, mnC);
#pragma unroll
  for (int r = 0; r < 16; ++r) p0[r] = __builtin_amdgcn_exp2f(p0[r]);
}
typedef int i32x8 __attribute__((ext_vector_type(8)));
__device__ __forceinline__ int cvt4_fp8(float a, float b, float c, float d) { int w = __builtin_amdgcn_cvt_pk_fp8_f32(a, b, 0, false); return __builtin_amdgcn_cvt_pk_fp8_f32(c, d, w, true); }
__device__ __forceinline__ void finishSM(f32x16& p0, f32x16& p1, i32x8& pf) {
#pragma unroll
  for (int r = 0; r < 16; ++r) p1[r] = __builtin_amdgcn_exp2f(p1[r]);
#pragma unroll
  for (int i = 0; i < 4; ++i) { pf[i] = cvt4_fp8(p0[4 * i], p0[4 * i + 1], p0[4 * i + 2], p0[4 * i + 3]); pf[4 + i] = cvt4_fp8(p1[4 * i], p1[4 * i + 1], p1[4 * i + 2], p1[4 * i + 3]); }
}
#define KSWZ8(row, colB) ((row) * 128 + ((colB) ^ ((((row) >> 1) & 7) << 4)))
__device__ __forceinline__ void qkt(f32x16& p0, f32x16& p1, const char* Ks, const i32x8* qr, int r32, int hi) {
  p0 = f32x16{}; p1 = f32x16{};
#pragma unroll
  for (int d0 = 0; d0 < 2; ++d0) { const int cb = d0 * 64 + hi * 32;
    const i32x4 a0 = *reinterpret_cast<const i32x4*>(Ks + KSWZ8(r32, cb)), a1 = *reinterpret_cast<const i32x4*>(Ks + KSWZ8(r32, cb + 16));
    const i32x4 b0 = *reinterpret_cast<const i32x4*>(Ks + KSWZ8(32 + r32, cb)), b1 = *reinterpret_cast<const i32x4*>(Ks + KSWZ8(32 + r32, cb + 16));
    const i32x8 k0 = {a0[0], a0[1], a0[2], a0[3], a1[0], a1[1], a1[2], a1[3]}, k1 = {b0[0], b0[1], b0[2], b0[3], b1[0], b1[1], b1[2], b1[3]};
    p0 = __builtin_amdgcn_mfma_scale_f32_32x32x64_f8f6f4(k0, qr[d0], p0, 0, 0, 0, 0x7f7f7f7f, 0, 0x7f7f7f7f);
    p1 = __builtin_amdgcn_mfma_scale_f32_32x32x64_f8f6f4(k1, qr[d0], p1, 0, 0, 0, 0x7f7f7f7f, 0, 0x7f7f7f7f); }
}
__device__ __forceinline__ void pv_fp8(f32x16* o, f32x16& ol, const char* Vt, int voA, int voB, const i32x8 pf) {
  const i32x8 ones = {0x38383838, 0x38383838, 0x38383838, 0x38383838, 0x38383838, 0x38383838, 0x38383838, 0x38383838};
  ol = __builtin_amdgcn_mfma_scale_f32_32x32x64_f8f6f4(pf, ones, ol, 0, 0, 0, 0x7f7f7f7f, 0, 0x7f7f7f7f);
#pragma unroll
  for (int d0 = 0; d0 < 4; ++d0) {
    const i32x4 a = *reinterpret_cast<const i32x4*>(Vt + d0 * 2048 + voA), b = *reinterpret_cast<const i32x4*>(Vt + d0 * 2048 + voB);
    const i32x8 vf = {a[0], a[1], a[2], a[3], b[0], b[1], b[2], b[3]};
    o[d0] = __builtin_amdgcn_mfma_scale_f32_32x32x64_f8f6f4(pf, vf, o[d0], 0, 0, 0, 0x7f7f7f7f, 0, 0x7f7f7f7f);
  }
}
__device__ __forceinline__ float bflo(unsigned w) { return __uint_as_float(w << 16); }
__device__ __forceinline__ float bfhi(unsigned w) { return __uint_as_float(w & 0xffff0000u); }
struct Merge { const bf16* SGA; const bf16* GBS; const bf16* P; const float* cw; const float* cb; };
__device__ __forceinline__ void attn_unit(const signed char* __restrict__ Qb, bf16* __restrict__ Ob, const signed char* __restrict__ Kh, const unsigned char* __restrict__ Vh, int seq, int t0, size_t grow0, int h,
                                          const Merge& mg, char* lds, char* scr, int tid) {
  const int wid = tid >> 6, lane = tid & 63, r32 = lane & 31, hi = lane >> 5;
  char* V_lds = lds; char* K_lds = lds + 2 * SHM_K8;
  float* al_l = (float*)scr + wid * 64 + 32;
  float m_reg = -1e30f; f32x16 o[4] = {}, ol = {}; i32x8 qr[2];
  const signed char* Qw = Qb + (long)(wid * QBLK + r32) * LDQ + hi * 32;
#pragma unroll
  for (int d0 = 0; d0 < 2; ++d0) { const i32x4 a = *reinterpret_cast<const i32x4*>(Qw + d0 * 64), b = *reinterpret_cast<const i32x4*>(Qw + d0 * 64 + 16); qr[d0] = (i32x8){a[0], a[1], a[2], a[3], b[0], b[1], b[2], b[3]}; }
  const int vd = tid >> 2, vst = vd * 64 + (((tid & 3) ^ ((vd >> 2) & 3)) << 4);
  const int vsw = (r32 >> 2) & 3, voA = r32 * 64 + (((2 * hi) ^ vsw) << 4), voB = r32 * 64 + (((2 * hi + 1) ^ vsw) << 4);
  struct { i32x4 vs, ks; } sr_[2];
  const int kr = tid >> 3, kc = (tid & 7) * 16; const unsigned ko8 = (unsigned)(kr * LDK + kc);
  const unsigned vo8 = (unsigned)tid * 16u;
#define SLOAD(i, k0) do { const unsigned char* vt_ = Vh + (size_t)(k0) * 128; const signed char* kt_ = Kh + (size_t)(k0) * LDK; \
    sr_[i].vs = *reinterpret_cast<const i32x4*>(vt_ + vo8); sr_[i].ks = *reinterpret_cast<const i32x4*>(kt_ + ko8); } while (0)
#define SWRITE(b, i) do { *(i32x4*)(V_lds + (b) * SHM_K8 + vst) = sr_[i].vs; *(i32x4*)(K_lds + (b) * SHM_K8 + KSWZ8(kr, kc)) = sr_[i].ks; } while (0)
#define SWAIT() asm volatile("s_waitcnt vmcnt(2)" ::: "memory")
#define RESC(a) do { if (__any((a) < 1.f)) { if (hi == 0) al_l[r32] = (a); asm volatile("s_waitcnt lgkmcnt(0)" ::: "memory"); \
    _Pragma("unroll") for (int r = 0; r < 16; ++r) { const float a_ = al_l[crow(r, hi)]; ol[r] *= a_; _Pragma("unroll") for (int d = 0; d < 4; ++d) o[d][r] *= a_; } } } while (0)
  f32x16 pA0, pA1, pB0, pB1; float mnA, mnB, alA, alB; i32x8 pf; const int NT = seq / KVBLK;
  constexpr int SE = 0, SO = 1;
  SLOAD(SE, 0); asm volatile("s_waitcnt vmcnt(0)" ::: "memory"); SWRITE(0, SE); __syncthreads();
  qkt(pA0, pA1, K_lds, qr, r32, hi); partialSM(pA0, pA1, m_reg, mnA, alA);
  SLOAD(SO, KVBLK); if (2 < NT) SLOAD(SE, 2 * KVBLK);
  SWAIT(); SWRITE(1, SO); __syncthreads();
  for (int j = 1; j + 1 < NT; j += 2) {
    SBAR(); qkt(pB0, pB1, K_lds + SHM_K8, qr, r32, hi);
    finishSM(pA0, pA1, pf); SBAR();
    SLOAD(SO, (j + 2) * KVBLK); SBAR();
    pv_fp8(o, ol, V_lds, voA, voB, pf); partialSM(pB0, pB1, m_reg, mnB, alB);
    __syncthreads(); SWAIT(); SWRITE(0, SE);
    RESC(alB); __syncthreads();
    SBAR(); qkt(pA0, pA1, K_lds, qr, r32, hi);
    finishSM(pB0, pB1, pf); SBAR();
    if (j + 3 < NT) SLOAD(SE, (j + 3) * KVBLK); SBAR();
    pv_fp8(o, ol, V_lds + SHM_K8, voA, voB, pf); partialSM(pA0, pA1, m_reg, mnA, alA);
    __syncthreads(); SWAIT(); SWRITE(1, SO);
    RESC(alA); __syncthreads();
  }
  SBAR(); qkt(pB0, pB1, K_lds + SHM_K8, qr, r32, hi);
  finishSM(pA0, pA1, pf); SBAR();
  pv_fp8(o, ol, V_lds, voA, voB, pf); partialSM(pB0, pB1, m_reg, mnB, alB);
  __syncthreads(); RESC(alB);
  finishSM(pB0, pB1, pf); SBAR();
  pv_fp8(o, ol, V_lds + SHM_K8, voA, voB, pf);
  float rli[16];
#pragma unroll
  for (int r = 0; r < 16; ++r) rli[r] = __builtin_amdgcn_rcpf(ol[r]);
  asm volatile("s_waitcnt vmcnt(0) lgkmcnt(0)" ::: "memory");
  __syncthreads();
  float* OS = (float*)(lds + wid * 16384);
#pragma unroll
  for (int r = 0; r < 16; ++r) { const int orow = crow(r, hi);
#pragma unroll
    for (int d0 = 0; d0 < 4; ++d0) OS[orow * 128 + d0 * 32 + r32] = o[d0][r] * rli[r]; }
  asm volatile("s_waitcnt lgkmcnt(0)" ::: "memory");
  int tid2 = tid; asm volatile("" : "+v"(tid2));
  const int lane2 = tid2 & 63, cg = lane2 & 15, rl = lane2 >> 4, col = h * 128 + cg * 8, widu = __builtin_amdgcn_readfirstlane(tid2 >> 6);
  float w0[8], w1[8], w2[8], cbv[8];
#pragma unroll
  for (int e = 0; e < 8; ++e) { w0[e] = mg.cw[col + e]; w1[e] = mg.cw[DM + col + e]; w2[e] = mg.cw[2 * DM + col + e]; cbv[e] = mg.cb[col + e]; }
  const size_t wbase = (grow0 + (size_t)(widu * 32)) * DM + (size_t)(h * 128);
  const unsigned loff = (unsigned)(rl * DM + cg * 8);
  const float* OSr = OS + rl * 128 + cg * 8;
  struct MgLd { u32x4 sg, gb, pc, pm, pp; };
#define MG_LOAD(PS, D) do { const int ps_ = (PS); const int t_ = t0 + widu * 32 + ps_ * 4 + rl; const size_t ub_ = wbase + (size_t)(ps_ * 4) * DM; \
    const bf16* pcp_ = mg.P + ub_; (D).sg = *(const u32x4*)(mg.SGA + ub_ + loff); (D).gb = *(const u32x4*)(mg.GBS + ub_ + loff); (D).pc = *(const u32x4*)(pcp_ + loff); \
    (D).pm = (u32x4){0u, 0u, 0u, 0u}; (D).pp = (u32x4){0u, 0u, 0u, 0u}; if (t_ > 0) (D).pm = *(const u32x4*)(pcp_ - DM + loff); if (t_ < seq - 1) (D).pp = *(const u32x4*)(pcp_ + DM + loff); } while (0)
#define MG_COMP(PS, D) do { const int ps_ = (PS); const f32x4 a0 = *(const f32x4*)(OSr + ps_ * 512), a1 = *(const f32x4*)(OSr + ps_ * 512 + 4); \
    const float av[8] = {a0[0], a0[1], a0[2], a0[3], a1[0], a1[1], a1[2], a1[3]}; float ov[8]; \
    _Pragma("unroll") for (int e = 0; e < 8; ++e) { const unsigned wsg = (D).sg[e >> 1], wgb = (D).gb[e >> 1], wpc = (D).pc[e >> 1], wpm = (D).pm[e >> 1], wpp = (D).pp[e >> 1]; \
      const float fsg = (e & 1) ? bfhi(wsg) : bflo(wsg), fgb = (e & 1) ? bfhi(wgb) : bflo(wgb), fpc = (e & 1) ? bfhi(wpc) : bflo(wpc), fpm = (e & 1) ? bfhi(wpm) : bflo(wpm), fpp = (e & 1) ? bfhi(wpp) : bflo(wpp); \
      const float cv = fmaf(w0[e], fpm, fmaf(w1[e], fpc, fmaf(w2[e], fpp, cbv[e]))); ov[e] = fmaf(fsg, av[e], fgb * cv); } \
    u32x4 w_; w_.x = cvtpk(ov[0], ov[1]); w_.y = cvtpk(ov[2], ov[3]); w_.z = cvtpk(ov[4], ov[5]); w_.w = cvtpk(ov[6], ov[7]); \
    *(u32x4*)(Ob + (size_t)(widu * 32 + ps_ * 4) * LDQ + loff) = w_; } while (0)
  MgLd LA, LB;
  MG_LOAD(0, LA);
#pragma unroll 1
  for (int ps = 0; ps < 8; ps += 2) { MG_LOAD(ps + 1, LB); MG_COMP(ps, LA); if (ps + 2 < 8) MG_LOAD(ps + 2, LA); MG_COMP(ps + 1, LB); }
#undef MG_LOAD
#undef MG_COMP
  asm volatile("s_waitcnt lgkmcnt(0)" ::: "memory");
  __syncthreads();
#undef SLOAD
#undef SWRITE
#undef SWAIT
#undef RESC
}
}

typedef GAS unsigned gu32;
#define RLX_AGENT __ATOMIC_RELAXED, __HIP_MEMORY_SCOPE_AGENT
#define LDS_WAIT() asm volatile("s_waitcnt lgkmcnt(0)" ::: "memory")
#define VM_WAIT() asm volatile("s_waitcnt vmcnt(0)" ::: "memory")
__device__ __forceinline__ unsigned f2bf(float f) { unsigned u = __builtin_bit_cast(unsigned, f); return (u + 0x7fffu + ((u >> 16) & 1u)) >> 16; }
__device__ __forceinline__ unsigned pk2(float lo, float hi) { unsigned r; asm volatile("v_cvt_pk_bf16_f32 %0, %1, %2" : "=v"(r) : "v"(lo), "v"(hi)); return r; }
__device__ __forceinline__ float bflo(unsigned w) { return __uint_as_float(w << 16); }
__device__ __forceinline__ float bfhi(unsigned w) { return __uint_as_float(w & 0xffff0000u); }

#define XB_TMO      128
#define XB_XCNT(j)  (256  + 64 * (j))
#define XB_XSUB(j)  (1280 + 64 * (j))
#define XB_XGEN(j)  (2304 + 64 * (j))
#define XB_TOP      3328
#define XB_TOPGEN   3392
#define XCD_BAR_WORDS 3456
#define XB_SPIN_CAP (1u << 18)
__device__ __forceinline__ unsigned xb_ld(unsigned* p)              { return __hip_atomic_load(p, __ATOMIC_RELAXED, __HIP_MEMORY_SCOPE_AGENT); }
__device__ __forceinline__ unsigned xb_add(unsigned* p, unsigned v) { return __hip_atomic_fetch_add(p, v, __ATOMIC_RELAXED, __HIP_MEMORY_SCOPE_AGENT); }
__device__ __forceinline__ unsigned xb_xcc_id() { return (unsigned)__builtin_amdgcn_s_getreg((3 << 11) | 20) & 0xFu; }
#define XB_SPIN(cond, bar) do { unsigned _sp = 0; while (cond) { __builtin_amdgcn_s_sleep(1); \
    if ((++_sp & 255u) == 0u) { if (xb_ld(&(bar)[XB_TMO])) break; if (_sp > XB_SPIN_CAP) { atomicAdd(&(bar)[XB_TMO], 1u); break; } } } } while (0)
struct XcdBarrier { unsigned* bar; unsigned x; volatile LAS unsigned* st; };
__device__ __forceinline__ XcdBarrier xcd_barrier_post(unsigned* bar, volatile LAS unsigned* st) {
    XcdBarrier b; b.bar = bar; b.x = xb_xcc_id(); b.st = st;
    if (threadIdx.x == 0) (void)xb_add(&bar[XB_XCNT(b.x)], 1u);
    return b;
}
__device__ __forceinline__ void xcd_barrier_complete(unsigned* bar, unsigned x, unsigned& nloc, unsigned& nx) {
    const unsigned G = gridDim.x * gridDim.y * gridDim.z;
    unsigned sum, cnt, mine, sp = 0u;
    for (;;) {
        sum = 0u; cnt = 0u; mine = 0u;
#pragma unroll
        for (unsigned j = 0; j < 16; ++j) { const unsigned c = xb_ld(&bar[XB_XCNT(j)]); sum += c; cnt += (c > 0u) ? 1u : 0u; mine = (j == x) ? c : mine; }
        if (sum == G) break;
        __builtin_amdgcn_s_sleep(1);
        if ((++sp & 255u) == 0u) { if (xb_ld(&bar[XB_TMO])) break; if (sp > XB_SPIN_CAP) { atomicAdd(&bar[XB_TMO], 1u); break; } }
    }
    nloc = mine > 0u ? mine : 1u; nx = cnt > 0u ? cnt : 1u;
}
__device__ __forceinline__ void xcd_barrier(const XcdBarrier& b) {
    asm volatile("s_waitcnt vmcnt(0)" ::: "memory");
    __syncthreads();
    if (threadIdx.x == 0) {
        unsigned* bar = b.bar;
        __builtin_amdgcn_s_waitcnt(0);
        unsigned nloc = b.st[0], nx = b.st[1];
        if (nloc == 0u) { xcd_barrier_complete(bar, b.x, nloc, nx); b.st[0] = nloc; b.st[1] = nx; }
        const unsigned old = xb_add(&bar[XB_XSUB(b.x)], 1u);
        const unsigned gen = old / nloc;
        if (old + 1u == (gen + 1u) * nloc) {
            __builtin_amdgcn_fence(__ATOMIC_RELEASE, "agent");
            asm volatile("s_waitcnt vmcnt(0)" ::: "memory");
            const unsigned og = xb_add(&bar[XB_TOP], 1u);
            const unsigned tg = og / nx;
            if (og + 1u == (tg + 1u) * nx) xb_add(&bar[XB_TOPGEN], 1u);
            else XB_SPIN(xb_ld(&bar[XB_TOPGEN]) == tg, bar);
            __builtin_amdgcn_fence(__ATOMIC_ACQUIRE, "agent");
            xb_add(&bar[XB_XGEN(b.x)], 1u);
            asm volatile("s_waitcnt vmcnt(0)" ::: "memory");
        } else {
            XB_SPIN(xb_ld(&bar[XB_XGEN(b.x)]) == gen, bar);
            __builtin_amdgcn_fence(__ATOMIC_ACQUIRE, "agent");
            asm volatile("s_waitcnt vmcnt(0)" ::: "memory");
        }
    }
    __syncthreads();
}

struct Args {
    const float *xp, *xs, *cp, *cs, *w_ada, *b_ada, *g_mix_pre, *w_in, *g_q, *g_k, *conv_w, *conv_b, *w_o, *g_mix_post, *g_ffn_pre, *w_up, *ffn_conv_w, *ffn_conv_b, *w_down, *g_ffn_post;
    float* out; unsigned char* ws; int ph_lo, ph_hi;
};
struct Frame { LAS unsigned char* lds; int tid, lane, wave, vcu, G; };
typedef const Args __attribute__((address_space(4)))* ArgsP;
__device__ __forceinline__ ArgsP kargs() { ArgsP p = (ArgsP)__builtin_amdgcn_kernarg_segment_ptr(); asm volatile("" : "+s"(p)); return p; }
__device__ __forceinline__ Frame make_frame(LAS unsigned char* lds) { Frame F; F.lds = lds; int t = threadIdx.x; asm volatile("" : "+v"(t)); F.tid = t; F.lane = t & 63; F.wave = __builtin_amdgcn_readfirstlane(t >> 6);
    F.G = gridDim.x; { const int bx = blockIdx.x; F.vcu = (F.G % 8 == 0) ? (bx % 8) * (F.G / 8) + bx / 8 : bx; } return F; }

__device__ __forceinline__ float wave_sum(float v) {
#pragma unroll
    for (int o = 1; o < 64; o <<= 1) v += __shfl_xor(v, o);
    return v;
}
__device__ __forceinline__ int seq_of(int m) { return m < MP ? (m >> 11) : 8; }
__device__ __forceinline__ int pos_of(int m) { return m < MP ? (m & (SEQP - 1)) : (m - MP); }
__device__ __forceinline__ const float* xrow(const float* xp, const float* xs, int m) { return m < MP ? xp + (size_t)m * DM : xs + (size_t)(m - MP) * DM; }

__device__ __forceinline__ int inA_logical(int np) {
    const int pn = np >> 8, c = np & 255;
    return (c < 128 ? 10240 : 14336) + 128 * pn + (c & 127);
}
__device__ __forceinline__ int inB_logical(int np) {
    if (np < 6144) return np;
    if (np < 10240) return np + 12288;
    const int pn = (np - 10240) >> 8, c = np & 255;
    return (c < 128 ? 6144 : 22528) + 128 * pn + (c & 127);
}
__device__ __forceinline__ int up_logical(int np) { const int pn = np >> 8, c = np & 255; return (c < 128 ? 0 : DFF) + 128 * pn + (c & 127); }

__device__ __forceinline__ int qk_perm6(int d) { return (d & 3) | (((d >> 5) & 1) << 2) | (((d >> 2) & 3) << 3) | (((d >> 4) & 1) << 5); }
template <bool QKP> __device__ __forceinline__ void transpose_item(const float* W, int K, int N, bf16* WT, int k0, int nlog0, int nphys0, LAS float* scr, int lane) {
    const float* src = W + (size_t)k0 * N + nlog0 + lane;
#pragma unroll 16
    for (int i = 0; i < 64; ++i) scr[i * 65 + lane] = src[(size_t)i * N];
    LDS_WAIT(); asm volatile("" ::: "memory");
    const int c = lane & 7, n8 = lane >> 3;
#pragma unroll
    for (int j = 0; j < 8; ++j) { const int n = n8 + 8 * j; const LAS float* s = scr + (8 * c) * 65 + n;
        u32x4 o; o.x = pk2(s[0], s[65]); o.y = pk2(s[2 * 65], s[3 * 65]); o.z = pk2(s[4 * 65], s[5 * 65]); o.w = pk2(s[6 * 65], s[7 * 65]);
        *(GAS u32x4*)(WT + (size_t)(nphys0 + (QKP ? qk_perm6(n) : n)) * K + k0 + 8 * c) = o; }
    LDS_WAIT(); asm volatile("" ::: "memory");
}

__device__ __forceinline__ void amax_item(bool QKP, const float* W, int N, int k0, int nlog0, int nphys0, unsigned* camax, int lane) {
    const float* src = W + (size_t)k0 * N + nlog0 + lane; float m = 0.f;
#pragma unroll 8
    for (int i = 0; i < 64; ++i) m = fmaxf(m, fabsf(src[(size_t)i * N]));
    (void)__hip_atomic_fetch_max(camax + nphys0 + (QKP ? qk_perm6(lane) : lane), __float_as_uint(m), __ATOMIC_RELAXED, __HIP_MEMORY_SCOPE_AGENT);
}
template <bool SAT> __device__ __forceinline__ unsigned pack_q8s(float a, float b, float c, float d, float s) {
    const float M = 12582912.0f; float ya, yb, yc, yd;
    if (SAT) { ya = __builtin_amdgcn_fmed3f(a * s, -127.f, 127.f) + M; yb = __builtin_amdgcn_fmed3f(b * s, -127.f, 127.f) + M; yc = __builtin_amdgcn_fmed3f(c * s, -127.f, 127.f) + M; yd = __builtin_amdgcn_fmed3f(d * s, -127.f, 127.f) + M; }
    else { ya = fmaf(a, s, M); yb = fmaf(b, s, M); yc = fmaf(c, s, M); yd = fmaf(d, s, M); }
    return __builtin_amdgcn_perm(__float_as_uint(yb), __float_as_uint(ya), 0x0c0c0400u) | __builtin_amdgcn_perm(__float_as_uint(yd), __float_as_uint(yc), 0x04000c0cu);
}
__device__ __forceinline__ unsigned pack_q8(float a, float b, float c, float d) { return pack_q8s<true>(a, b, c, d, 1.0f); }
__device__ __forceinline__ void transpose_item_i8(bool QKP, const float* W, int K, int N, signed char* W8, int k0, int nlog0, int nphys0, const unsigned* camax, float* swp, LAS float* scr, int lane) {
    const float* src = W + (size_t)k0 * N + nlog0 + lane;
#pragma unroll 16
    for (int i = 0; i < 64; ++i) scr[i * 65 + lane] = src[(size_t)i * N];
    LDS_WAIT(); asm volatile("" ::: "memory");
    const int c = lane & 3, n16 = lane >> 2;
#pragma unroll
    for (int j = 0; j < 4; ++j) { const int n = n16 + 16 * j, np = nphys0 + (QKP ? qk_perm6(n) : n); const LAS float* sp = scr + (16 * c) * 65 + n;
        const float amax = __uint_as_float(camax[np]), inv = amax > 0.f ? 127.0f / amax : 0.f;
        u32x4 o; o.x = pack_q8(sp[0] * inv, sp[65] * inv, sp[2 * 65] * inv, sp[3 * 65] * inv); o.y = pack_q8(sp[4 * 65] * inv, sp[5 * 65] * inv, sp[6 * 65] * inv, sp[7 * 65] * inv);
        o.z = pack_q8(sp[8 * 65] * inv, sp[9 * 65] * inv, sp[10 * 65] * inv, sp[11 * 65] * inv); o.w = pack_q8(sp[12 * 65] * inv, sp[13 * 65] * inv, sp[14 * 65] * inv, sp[15 * 65] * inv);
        *(GAS u32x4*)(W8 + (size_t)np * K + k0 + 16 * c) = o;
        if (k0 == 0 && c == 0) swp[np] = amax * (1.0f / 127.0f); }
    LDS_WAIT(); asm volatile("" ::: "memory");
}

__device__ __forceinline__ void fwht64(float (&v)[64]) {
#pragma unroll
    for (int st = 1; st < 64; st <<= 1)
#pragma unroll
        for (int i = 0; i < 64; ++i) if (!(i & st)) { const float a = v[i], b = v[i + st]; v[i] = a + b; v[i + st] = a - b; }
}
__device__ __forceinline__ f32x4 fwht64_row(f32x4 x, int lane) {
    { const float a = x[0] + x[1], b = x[0] - x[1], c = x[2] + x[3], d = x[2] - x[3]; x[0] = a + c; x[1] = b + d; x[2] = a - c; x[3] = b - d; }
#define FW_DPP(v, ctrl) __int_as_float(__builtin_amdgcn_update_dpp(0, __float_as_int(v), (ctrl), 0xf, 0xf, true))
#pragma unroll
    for (int e = 0; e < 4; ++e) { float own = x[e], pr;
        pr = FW_DPP(own, 0xB1); own = (lane & 1) ? pr - own : own + pr;
        pr = FW_DPP(own, 0x4E); own = (lane & 2) ? pr - own : own + pr;
        { const float up = FW_DPP(own, 0x104), dn = FW_DPP(own, 0x114); own = (lane & 4) ? dn - own : own + up; }
        { const float up = FW_DPP(own, 0x108), dn = FW_DPP(own, 0x118); own = (lane & 8) ? dn - own : own + up; }
        x[e] = own; }
#undef FW_DPP
    return x;
}
__device__ __forceinline__ void amax_item_h(bool QKP, const float* W, int N, int k0, int nlog0, int nphys0, unsigned* camax, int lane) {
    const float* src = W + (size_t)k0 * N + nlog0 + lane; float v[64];
#pragma unroll
    for (int i = 0; i < 64; ++i) v[i] = src[(size_t)i * N];
    fwht64(v); float m = 0.f;
#pragma unroll
    for (int i = 0; i < 64; ++i) m = fmaxf(m, fabsf(v[i]));
    (void)__hip_atomic_fetch_max(camax + nphys0 + (QKP ? qk_perm6(lane) : lane), __float_as_uint(m), __ATOMIC_RELAXED, __HIP_MEMORY_SCOPE_AGENT);
}
__device__ __forceinline__ void transpose_item_i8_h(bool QKP, const float* W, int K, int N, signed char* W8, int k0, int nlog0, int nphys0, const unsigned* camax, float* swp, int lane) {
    const float* src = W + (size_t)k0 * N + nlog0 + lane; float v[64];
#pragma unroll
    for (int i = 0; i < 64; ++i) v[i] = src[(size_t)i * N];
    fwht64(v);
    const int np = nphys0 + (QKP ? qk_perm6(lane) : lane); const float amax = AMX_SAFETY * __uint_as_float(camax[np]), inv = amax > 0.f ? 127.0f / amax : 0.f;
    GAS u32x4* dst = (GAS u32x4*)(W8 + (size_t)np * K + k0);
#pragma unroll
    for (int q = 0; q < 4; ++q) { u32x4 o; o.x = pack_q8s<true>(v[16 * q], v[16 * q + 1], v[16 * q + 2], v[16 * q + 3], inv); o.y = pack_q8s<true>(v[16 * q + 4], v[16 * q + 5], v[16 * q + 6], v[16 * q + 7], inv);
        o.z = pack_q8s<true>(v[16 * q + 8], v[16 * q + 9], v[16 * q + 10], v[16 * q + 11], inv); o.w = pack_q8s<true>(v[16 * q + 12], v[16 * q + 13], v[16 * q + 14], v[16 * q + 15], inv); dst[q] = o; }
    if (k0 == 0) swp[np] = amax * (1.0f / (127.0f * 64.0f));
}

__device__ __forceinline__ void transpose_item_i8_h2(bool QKP, const float* W, int K, int N, signed char* W8, int k0, int nlog0, int nphys0, const unsigned* camax, float* swp, int lane) {
    const float* src = W + (size_t)k0 * N + nlog0 + lane; float va[64], vb[64];
#pragma unroll
    for (int i = 0; i < 64; ++i) va[i] = src[(size_t)i * N];
#pragma unroll
    for (int i = 0; i < 64; ++i) vb[i] = src[(size_t)(64 + i) * N];
    fwht64(va); fwht64(vb);
    const int np = nphys0 + (QKP ? qk_perm6(lane) : lane); const float amax = AMX_SAFETY * __uint_as_float(camax[np]), inv = amax > 0.f ? 127.0f / amax : 0.f;
    GAS u32x4* dst = (GAS u32x4*)(W8 + (size_t)np * K + k0);
#pragma unroll
    for (int q = 0; q < 4; ++q) { u32x4 o; o.x = pack_q8s<true>(va[16 * q], va[16 * q + 1], va[16 * q + 2], va[16 * q + 3], inv); o.y = pack_q8s<true>(va[16 * q + 4], va[16 * q + 5], va[16 * q + 6], va[16 * q + 7], inv);
        o.z = pack_q8s<true>(va[16 * q + 8], va[16 * q + 9], va[16 * q + 10], va[16 * q + 11], inv); o.w = pack_q8s<true>(va[16 * q + 12], va[16 * q + 13], va[16 * q + 14], va[16 * q + 15], inv); dst[q] = o; }
#pragma unroll
    for (int q = 0; q < 4; ++q) { u32x4 o; o.x = pack_q8s<true>(vb[16 * q], vb[16 * q + 1], vb[16 * q + 2], vb[16 * q + 3], inv); o.y = pack_q8s<true>(vb[16 * q + 4], vb[16 * q + 5], vb[16 * q + 6], vb[16 * q + 7], inv);
        o.z = pack_q8s<true>(vb[16 * q + 8], vb[16 * q + 9], vb[16 * q + 10], vb[16 * q + 11], inv); o.w = pack_q8s<true>(vb[16 * q + 12], vb[16 * q + 13], vb[16 * q + 14], vb[16 * q + 15], inv); dst[4 + q] = o; }
    if (k0 == 0) swp[np] = amax * (1.0f / (127.0f * 64.0f));
}

__device__ __forceinline__ void sincos_d(double a, double& s, double& c) {
    const double TWO_PI_HI = 6.283185307179586, TWO_PI_LO = 2.4492935982947064e-16;
    const double k = __builtin_rint(a * 0.15915494309189535);
    double r = __builtin_fma(-k, TWO_PI_HI, a); r = __builtin_fma(-k, TWO_PI_LO, r);
    const double q = r * 0.25, z = q * q;
    double sp = -1.0 / 1307674368000.0; sp = sp * z + 1.0 / 6227020800.0; sp = sp * z - 1.0 / 39916800.0; sp = sp * z + 1.0 / 362880.0; sp = sp * z - 1.0 / 5040.0; sp = sp * z + 1.0 / 120.0; sp = sp * z - 1.0 / 6.0; sp = sp * z + 1.0;
    double cp = 1.0 / 20922789888000.0; cp = cp * z - 1.0 / 87178291200.0; cp = cp * z + 1.0 / 479001600.0; cp = cp * z - 1.0 / 3628800.0; cp = cp * z + 1.0 / 40320.0; cp = cp * z - 1.0 / 720.0; cp = cp * z + 1.0 / 24.0; cp = cp * z - 0.5; cp = cp * z + 1.0;
    double s1 = q * sp, c1 = cp;
    double s2 = 2.0 * s1 * c1, c2 = 1.0 - 2.0 * s1 * s1;
    s = 2.0 * s2 * c2; c = 1.0 - 2.0 * s2 * s2;
}

__device__ __forceinline__ void phase0(LAS unsigned char* lds_) {
    const ArgsP ap = kargs(); Frame F = make_frame(lds_);
    unsigned char* ws = ap->ws;
    { const int idx = blockIdx.x * 512 + F.tid;
      if (idx < 4096) { const int pos = idx >> 5, f = idx & 31; double inv = 1.0; for (int i = 0; i < f; ++i) inv *= 0.7498942093324558;
          double s, c; sincos_d((double)pos * inv, s, c); float* rope = (float*)(ws + WS_ROPE); rope[idx] = (float)c; rope[4096 + idx] = (float)s; } }
    float* mod = (float*)(ws + WS_MOD);
    {
        LAS float* sc = (LAS float*)(F.lds + F.wave * 6144);
        LAS float* RED = (LAS float*)(F.lds + 49152);
        const int sub = F.lane / 24, c4 = F.lane - 24 * sub; const bool actv = F.lane < 48; const int kw0 = F.wave * 512;
        for (int cb = blockIdx.x; cb < (6 * DM) / 96; cb += F.G) {
            const int n0 = cb * 96;
            f32x4 acc[9];
#pragma unroll
            for (int sq = 0; sq < 9; ++sq) acc[sq] = (f32x4){0.f, 0.f, 0.f, 0.f};
            for (int kc = 0; kc < 512; kc += 128) {
                for (int idx = F.lane; idx < 128 * 9; idx += 64) { const int k = idx / 9, sq = idx - 9 * k; const float c = sq < 8 ? ap->cp[sq * DM + kw0 + kc + k] : ap->cs[kw0 + kc + k]; sc[k * 12 + sq] = c / (1.0f + __expf(-c)); }
                LDS_WAIT(); asm volatile("" ::: "memory");
                if (actv) { const float* wp = ap->w_ada + (size_t)(kw0 + kc + sub) * (6 * DM) + n0 + 4 * c4;
#pragma unroll 8
                    for (int it = 0; it < 64; ++it) {
                        const f32x4 w = *(const f32x4*)(wp + (size_t)it * (2 * 6 * DM)); const LAS float* sr = sc + (2 * it + sub) * 12;
                        const f32x4 s0 = *(const LAS f32x4*)sr, s1 = *(const LAS f32x4*)(sr + 4), s2 = *(const LAS f32x4*)(sr + 8);
                        acc[0] += s0[0] * w; acc[1] += s0[1] * w; acc[2] += s0[2] * w; acc[3] += s0[3] * w;
                        acc[4] += s1[0] * w; acc[5] += s1[1] * w; acc[6] += s1[2] * w; acc[7] += s1[3] * w; acc[8] += s2[0] * w; } }
                LDS_WAIT(); asm volatile("" ::: "memory");
            }
            if (actv) {
#pragma unroll
                for (int sq = 0; sq < 9; ++sq) *(LAS f32x4*)(RED + ((F.wave * 2 + sub) * 9 + sq) * 96 + 4 * c4) = acc[sq]; }
            __syncthreads();
            for (int t = F.tid; t < 9 * 96; t += 512) { const int sq = t / 96, c = t - 96 * sq; float sum = ap->b_ada[n0 + c];
#pragma unroll
                for (int p = 0; p < 16; ++p) sum += RED[(p * 9 + sq) * 96 + c];
                mod[(size_t)sq * (6 * DM) + n0 + c] = sum; }
            __syncthreads();
        }
    }
    __syncthreads();
    LAS float* scr = (LAS float*)(F.lds + F.wave * TR_SCR);
    const int gw = F.vcu * 8 + F.wave, NGW = F.G * 8;
    constexpr int I_INA = 64 * (NINA / 64), I_AMX = 64 * (NINB / 64), I_O = 64 * 64;
    unsigned* camax = (unsigned*)(ws + WS_CAMAX);
    for (int it = gw; it < I_INA; it += NGW) { const int nb = NINA / 64, kb = it / nb, nbk = it - kb * nb; transpose_item<false>(ap->w_in, DM, NIN, (bf16*)(ws + WS_WIN), kb * 64, inA_logical(nbk * 64), nbk * 64, scr, F.lane); }
    if (T8 < NT_UP) for (int it = (gw + 1536) % NGW; it < 64 * (NT_UP - T8) * 4; it += NGW) { const int nb = (NT_UP - T8) * 4, kb = it / nb, np0 = T8 * 256 + (it - kb * nb) * 64; transpose_item<false>(ap->w_up, DM, NUP, (bf16*)(ws + WS_WUP), kb * 64, up_logical(np0), np0, scr, F.lane); }
    if (T8 > 0) { unsigned* camax2 = (unsigned*)(ws + WS_CAMAX2);
        for (int it = (gw + 1536) % NGW; it < (64 / AMX_STRIDE) * T8 * 4; it += NGW) { const int nb = T8 * 4, kb = (it / nb) * AMX_STRIDE, np0 = (it - (it / nb) * nb) * 64; if (UP_ROT) amax_item_h(false, ap->w_up, NUP, kb * 64, up_logical(np0), np0, camax2, F.lane); else amax_item(false, ap->w_up, NUP, kb * 64, up_logical(np0), np0, camax2, F.lane); } }
    for (int it = gw; it < I_O; it += NGW) { const int kb = it >> 6, nbk = it & 63; transpose_item<false>(ap->w_o, DM, DM, (bf16*)(ws + WS_WO), kb * 64, nbk * 64, nbk * 64, scr, F.lane); }
    { unsigned* camax3 = (unsigned*)(ws + WS_CAMAX3);
        for (int it = (gw + 512) % NGW; it < ((DFF / 64 + AMX_STRIDE - 1) / AMX_STRIDE) * 64; it += NGW) { const int kb = (it >> 6) * AMX_STRIDE, nbk = it & 63; amax_item_h(false, ap->w_down, DM, kb * 64, nbk * 64, nbk * 64, camax3, F.lane); } }
    for (int it = gw; it < I_AMX / AMX_STRIDE; it += NGW) { const int nb = NINB / 64, kb = (it / nb) * AMX_STRIDE, nbk = it - (it / nb) * nb;
        amax_item_h(nbk < 80, ap->w_in, NIN, kb * 64, inB_logical(nbk * 64), nbk * 64, camax, F.lane); }
}

__device__ __forceinline__ void tail_copy_wdown(LAS unsigned char* lds_, int nwg) {
    const ArgsP ap = kargs(); Frame F = make_frame(lds_);
    const int G = F.G, extra = nwg % G, bx = blockIdx.x;
    if (extra == 0 || bx < extra) return;
    const int nb = G - extra, gw = (bx - extra) * 8 + F.wave, NGW = nb * 8;
    LAS float* scr = (LAS float*)(F.lds + F.wave * TR_SCR);
    for (int it = gw; it < (DFF / 64) * 64; it += NGW) { const int kb = it >> 6, nbk = it & 63; transpose_item_i8_h(false, ap->w_down, DFF, DM, (signed char*)(ap->ws + WS_WDN), kb * 64, nbk * 64, nbk * 64, (const unsigned*)(ap->ws + WS_CAMAX3), (float*)(ap->ws + WS_SWD), F.lane); }
}

__device__ __forceinline__ void v8t_pass(LAS unsigned char* lds_) {
    const ArgsP ap = kargs(); Frame F = make_frame(lds_);
    const bf16* V = (const bf16*)(ap->ws + WS_V); unsigned char* V8T = ap->ws + WS_V8T;
    LAS unsigned char* T = F.lds + F.wave * TR_SCR;
    const int gw = F.vcu * 8 + F.wave, NGW = F.G * 8;
    for (int it = gw; it < 8 * (MROWS / 64); it += NGW) {
        const int kvh = it & 7, tile = it >> 3;
        const bf16* src = V + (size_t)tile * 64 * KVD + kvh * 128 + (F.lane & 15) * 8;
#pragma unroll 4
        for (int ps = 0; ps < 16; ++ps) {
            const int kap = 4 * ps + (F.lane >> 4);
            const u32x4 w = *(const u32x4*)(src + (size_t)kap * KVD);
            const int pos = 32 * ((kap >> 2) & 1) + 16 * (kap >> 5) + (kap & 3) + 4 * ((kap & 31) >> 3);
            const int lo = att::cvt4_fp8(att::bflo(w.x), att::bfhi(w.x), att::bflo(w.y), att::bfhi(w.y)), hi4 = att::cvt4_fp8(att::bflo(w.z), att::bfhi(w.z), att::bflo(w.w), att::bfhi(w.w));
            LAS unsigned char* t = T + ((F.lane & 15) * 8) * 80 + pos;
            t[0] = (unsigned char)lo; t[80] = (unsigned char)(lo >> 8); t[160] = (unsigned char)(lo >> 16); t[240] = (unsigned char)(lo >> 24);
            t[320] = (unsigned char)hi4; t[400] = (unsigned char)(hi4 >> 8); t[480] = (unsigned char)(hi4 >> 16); t[560] = (unsigned char)(hi4 >> 24);
        }
        LDS_WAIT(); asm volatile("" ::: "memory");
        unsigned char* dst = V8T + (size_t)(kvh * (MROWS / 64) + tile) * 8192;
#pragma unroll
        for (int q = 0; q < 8; ++q) { const int id = q * 64 + F.lane; *(u32x4*)(dst + id * 16) = *(const LAS u32x4*)(T + (id >> 2) * 80 + (id & 3) * 16); }
        LDS_WAIT(); asm volatile("" ::: "memory");
    }
}

__device__ __forceinline__ void hadamard_frags(bf16x8 (&HA)[8], int lane) {
    const int fr = lane & 15, fq = lane >> 4;
#pragma unroll
    for (int mi = 0; mi < 4; ++mi)
#pragma unroll
        for (int ks = 0; ks < 2; ++ks) { bf16x8 a;
#pragma unroll
            for (int i = 0; i < 8; ++i) a[i] = (short)((__builtin_popcount((16 * mi + fr) & (32 * ks + 8 * fq + i)) & 1) ? 0xBF80 : 0x3F80);
            HA[2 * mi + ks] = a; }
}
__device__ __forceinline__ void hadamard_rows_mfma(f32x4 (&C)[16], const bf16x8 (&HA)[8], LAS unsigned char* buf, int lane) {
    const int fr = lane & 15, fq = lane >> 4;
    bf16x8 B[8];
#pragma unroll
    for (int nj = 0; nj < 4; ++nj)
#pragma unroll
        for (int ks = 0; ks < 2; ++ks) B[2 * nj + ks] = *(const LAS bf16x8*)(buf + (16 * nj + fr) * 144 + (32 * ks + 8 * fq) * 2);
#pragma unroll
    for (int mi = 0; mi < 4; ++mi)
#pragma unroll
        for (int nj = 0; nj < 4; ++nj) { f32x4 c = {0.f, 0.f, 0.f, 0.f};
            c = __builtin_amdgcn_mfma_f32_16x16x32_bf16(HA[2 * mi], B[2 * nj], c, 0, 0, 0); c = __builtin_amdgcn_mfma_f32_16x16x32_bf16(HA[2 * mi + 1], B[2 * nj + 1], c, 0, 0, 0);
            C[4 * mi + nj] = c; }
}
__device__ __forceinline__ void phase_rows_u(LAS unsigned char* lds_) {
    const ArgsP ap = kargs(); Frame F = make_frame(lds_);
    const int gw = F.vcu * 8 + F.wave, NGW = F.G * 8; const float* mod = (const float*)(ap->ws + WS_MOD); bf16* U = (bf16*)(ap->ws + WS_U);
    unsigned char* U8 = (unsigned char*)ap->out + OUT_U8; float* SU = (float*)(ap->ws + WS_SU);
    {
        LAS float* scr = (LAS float*)(F.lds + F.wave * TR_SCR); const unsigned* camax = (const unsigned*)(ap->ws + WS_CAMAX); float* swp = (float*)(ap->ws + WS_SWP); signed char* W8 = (signed char*)(ap->ws + WS_W8);
        for (int it = gw; it < 32 * (NINB / 64); it += NGW) { const int nb = NINB / 64, kb = it / nb, nbk = it - kb * nb;
            transpose_item_i8_h2(nbk < 80, ap->w_in, DM, NIN, W8, kb * 128, inB_logical(nbk * 64), nbk * 64, camax, swp, F.lane); }        if (T8 > 0) { const unsigned* camax2 = (const unsigned*)(ap->ws + WS_CAMAX2); float* swpu = (float*)(ap->ws + WS_SWPU); signed char* W8U = (signed char*)(ap->ws + WS_WUP);
            for (int it = (gw + 1024) % NGW; it < (UP_ROT ? 32 : 64) * T8 * 4; it += NGW) { const int nb = T8 * 4, kb = it / nb, np0 = (it - kb * nb) * 64; if (UP_ROT) transpose_item_i8_h2(false, ap->w_up, DM, NUP, W8U, kb * 128, up_logical(np0), np0, camax2, swpu, F.lane); else transpose_item_i8(false, ap->w_up, DM, NUP, W8U, kb * 64, up_logical(np0), np0, camax2, swpu, scr, F.lane); } }
    }
    __syncthreads();
    LAS f32x4* VL = (LAS f32x4*)F.lds; LAS unsigned char* hb = F.lds + 32768 + F.wave * 9216;
    bf16x8 HA[8]; hadamard_frags(HA, F.lane);
    const int NSTEP = (MROWS / 8 + F.G - 1) / F.G;
    int cur = -1;
    f32x4 xv[16];
    { const int mf = F.vcu * NSTEP * 8 + F.wave; if (mf < MROWS) { const f32x4* xr0 = (const f32x4*)xrow(ap->xp, ap->xs, mf) + F.lane;
#pragma unroll
        for (int j = 0; j < 16; ++j) xv[j] = xr0[64 * j]; } }
    for (int i = 0; i < NSTEP; ++i) {
        const int m0 = (F.vcu * NSTEP + i) * 8; if (m0 >= MROWS) break;
        const int m = m0 + F.wave, sq = seq_of(m0), mnx = (i + 1 < NSTEP && m0 + 8 < MROWS) ? m + 8 : m;
        if (sq != cur) {
            __syncthreads();
            const f32x4* md4 = (const f32x4*)(mod + (size_t)sq * (6 * DM)); const f32x4* gpr = (const f32x4*)ap->g_mix_pre;
            for (int c = F.tid; c < 1024; c += 512) { VL[c] = gpr[c] * (1.0f + md4[1024 + c]); VL[1024 + c] = md4[c]; }
            __syncthreads(); cur = sq;
        }
        f32x4 v[16]; float s = 0.f;
#pragma unroll
        for (int j = 0; j < 16; ++j) { v[j] = xv[j]; s += (v[j][0] * v[j][0] + v[j][1] * v[j][1]) + (v[j][2] * v[j][2] + v[j][3] * v[j][3]); }
        { const f32x4* xrn = (const f32x4*)xrow(ap->xp, ap->xs, mnx) + F.lane;
#pragma unroll
          for (int j = 0; j < 16; ++j) xv[j] = xrn[64 * j]; }
        const float rstd = 1.0f / sqrtf(wave_sum(s) * (1.0f / DM) + NORM_EPS); float am = 0.f;
#pragma unroll
        for (int j = 0; j < 16; ++j) { const int c = F.lane + 64 * j;
            const f32x4 u = (v[j] * rstd) * VL[c] + VL[1024 + c];
            u32x2 w; w.x = pk2(u[0], u[1]); w.y = pk2(u[2], u[3]);
            *(u32x2*)(U + (size_t)m * DM + 4 * c) = w;
            *(LAS u32x2*)(hb + (4 * j + (F.lane >> 4)) * 144 + (F.lane & 15) * 8) = w; }
        LDS_WAIT();
        f32x4 C[16]; hadamard_rows_mfma(C, HA, hb, F.lane);
#pragma unroll
        for (int t = 0; t < 16; ++t) am = fmaxf(fmaxf(am, fmaxf(fabsf(C[t][0]), fabsf(C[t][1]))), fmaxf(fabsf(C[t][2]), fabsf(C[t][3])));
#pragma unroll
        for (int o = 1; o < 64; o <<= 1) am = fmaxf(am, __shfl_xor(am, o));
        const float inv = am > 0.f ? 127.0f / am : 0.f;
        if (F.lane == 0) SU[m] = am * (1.0f / 127.0f);
        LDS_WAIT();
#pragma unroll
        for (int mi = 0; mi < 4; ++mi)
#pragma unroll
            for (int nj = 0; nj < 4; ++nj) { const f32x4 c = C[4 * mi + nj];
                *(LAS unsigned*)(hb + (16 * nj + (F.lane & 15)) * 64 + 16 * mi + 4 * (F.lane >> 4)) = pack_q8s<false>(c[0], c[1], c[2], c[3], inv); }
        LDS_WAIT();
#pragma unroll
        for (int q = 0; q < 4; ++q) *(u32x4*)(U8 + (size_t)m * DM + q * 1024 + F.lane * 16) = *(const LAS u32x4*)(hb + q * 1024 + F.lane * 16);
        LDS_WAIT();
    }
    __syncthreads();
}

__device__ __forceinline__ void phase_rows_mid(LAS unsigned char* lds_) {
    const ArgsP ap = kargs(); Frame F = make_frame(lds_);
    const float* mod = (const float*)(ap->ws + WS_MOD); bf16* U = (bf16*)(ap->ws + WS_U); const bf16* OUT = (const bf16*)(ap->ws + WS_OUT);
    unsigned char* U28 = ap->ws + WS_U28; float* SU2 = (float*)(ap->ws + WS_SU2);
    LAS f32x4* VL = (LAS f32x4*)F.lds;
    LAS unsigned char* hb = F.lds + 49152 + F.wave * 9216;
    bf16x8 HA[8]; hadamard_frags(HA, F.lane);
    const int NSTEP = (MROWS / 8 + F.G - 1) / F.G;
    int cur = -1;
    f32x4 xv[16];
    { const int mf = F.vcu * NSTEP * 8 + F.wave; if (mf < MROWS) { const f32x4* xr0 = (const f32x4*)xrow(ap->xp, ap->xs, mf) + F.lane;
#pragma unroll
        for (int j = 0; j < 16; ++j) xv[j] = xr0[64 * j]; } }
    for (int i = 0; i < NSTEP; ++i) {
        const int m0 = (F.vcu * NSTEP + i) * 8; if (m0 >= MROWS) break;
        const int m = m0 + F.wave, sq = seq_of(m0), mnx = (i + 1 < NSTEP && m0 + 8 < MROWS) ? m + 8 : m;
        if (sq != cur) {
            __syncthreads();
            const f32x4* md4 = (const f32x4*)(mod + (size_t)sq * (6 * DM)); const f32x4* gpo = (const f32x4*)ap->g_mix_post; const f32x4* gfp = (const f32x4*)ap->g_ffn_pre;
            for (int c = F.tid; c < 1024; c += 512) { VL[c] = md4[2 * 1024 + c] * gpo[c]; VL[1024 + c] = gfp[c] * (1.0f + md4[4 * 1024 + c]); VL[2048 + c] = md4[3 * 1024 + c]; }
            __syncthreads(); cur = sq;
        }
        f32x4 h[16]; float s = 0.f;
#pragma unroll
        for (int j = 0; j < 16; ++j) { const u32x2 w = *(const u32x2*)(OUT + (size_t)m * DM + 4 * (F.lane + 64 * j)); h[j] = (f32x4){bflo(w.x), bfhi(w.x), bflo(w.y), bfhi(w.y)};
            s += (h[j][0] * h[j][0] + h[j][1] * h[j][1]) + (h[j][2] * h[j][2] + h[j][3] * h[j][3]); }
        const float rstd1 = 1.0f / sqrtf(wave_sum(s) * (1.0f / DM) + NORM_EPS);
        float s2 = 0.f;
#pragma unroll
        for (int j = 0; j < 16; ++j) { const int c = F.lane + 64 * j;
            h[j] = xv[j] + VL[c] * (h[j] * rstd1);
            { u32x2 hw; hw.x = pk2(h[j][0], h[j][1]); hw.y = pk2(h[j][2], h[j][3]); *(u32x2*)(U + (size_t)m * DM + 4 * c) = hw; }
            s2 += (h[j][0] * h[j][0] + h[j][1] * h[j][1]) + (h[j][2] * h[j][2] + h[j][3] * h[j][3]); }
        { const f32x4* xrn = (const f32x4*)xrow(ap->xp, ap->xs, mnx) + F.lane;
#pragma unroll
          for (int j = 0; j < 16; ++j) xv[j] = xrn[64 * j]; }
        const float rstd2 = 1.0f / sqrtf(wave_sum(s2) * (1.0f / DM) + NORM_EPS); float am = 0.f;
#pragma unroll
        for (int j = 0; j < 16; ++j) { const int c = F.lane + 64 * j;
            const f32x4 u = (h[j] * rstd2) * VL[1024 + c] + VL[2048 + c];
            u32x2 w; w.x = pk2(u[0], u[1]); w.y = pk2(u[2], u[3]);
            *(LAS u32x2*)(hb + (4 * j + (F.lane >> 4)) * 144 + (F.lane & 15) * 8) = w; }
        LDS_WAIT();
        f32x4 C[16]; hadamard_rows_mfma(C, HA, hb, F.lane);
#pragma unroll
        for (int t = 0; t < 16; ++t) am = fmaxf(fmaxf(am, fmaxf(fabsf(C[t][0]), fabsf(C[t][1]))), fmaxf(fabsf(C[t][2]), fabsf(C[t][3])));
#pragma unroll
        for (int o = 1; o < 64; o <<= 1) am = fmaxf(am, __shfl_xor(am, o));
        const float inv = am > 0.f ? 127.0f / am : 0.f;
        if (F.lane == 0) SU2[m] = am * (1.0f / 127.0f);
        LDS_WAIT();
#pragma unroll
        for (int mi = 0; mi < 4; ++mi)
#pragma unroll
            for (int nj = 0; nj < 4; ++nj) { const f32x4 c = C[4 * mi + nj];
                *(LAS unsigned*)(hb + (16 * nj + (F.lane & 15)) * 64 + 16 * mi + 4 * (F.lane >> 4)) = pack_q8s<false>(c[0], c[1], c[2], c[3], inv); }
        LDS_WAIT();
#pragma unroll
        for (int q = 0; q < 4; ++q) *(u32x4*)(U28 + (size_t)m * DM + q * 1024 + F.lane * 16) = *(const LAS u32x4*)(hb + q * 1024 + F.lane * 16);
        LDS_WAIT();
    }
    __syncthreads();
}

__device__ __forceinline__ void phase_fixup(LAS unsigned char* lds_) {
    const ArgsP ap = kargs(); Frame F = make_frame(lds_);
    const int gw = F.vcu * 8 + F.wave, NGW = F.G * 8; const float* SB = (const float*)(ap->ws + WS_SB); bf16* ACT = (bf16*)(ap->ws + WS_ACT);
    constexpr int NCB = 22, NSTRIP = MROWS / 128;
    for (int it = gw; it < NSTRIP * 2 * NCB; it += NGW) {
        const int cb = it % NCB, sl = it / NCB, strip = sl >> 1, last = sl & 1, f0 = cb * 512 + F.lane * 8;
        if (f0 >= DFF) continue;
        const int row = strip * 128 + (last ? 127 : 0), seqlen = row < MP ? SEQP : SEQS, t = row < MP ? (row & (SEQP - 1)) : (row - MP);
        const bool has_nb = last ? (t != seqlen - 1) : (t != 0);
        const int pc = 256 * (f0 >> 7) + (f0 & 127);
        const float* part = SB + ((size_t)strip * 4 + (last ? 3 : 2)) * NUP + pc;
        const float* nb = SB + ((size_t)(last ? strip + 1 : strip - 1) * 4 + (last ? 0 : 1)) * NUP + pc;
        const float* wrow = ap->ffn_conv_w + (last ? 2 * NUP : 0);
        float ov[8];
#pragma unroll
        for (int h = 0; h < 2; ++h) {
            const f32x4 pa = *(const f32x4*)(part + 4 * h), pb = *(const f32x4*)(part + 128 + 4 * h);
            f32x4 na = (f32x4){0.f, 0.f, 0.f, 0.f}, nbv = na;
            if (has_nb) { na = *(const f32x4*)(nb + 4 * h); nbv = *(const f32x4*)(nb + 128 + 4 * h); }
            const f32x4 wa = *(const f32x4*)(wrow + f0 + 4 * h), wb = *(const f32x4*)(wrow + DFF + f0 + 4 * h);
            const f32x4 za = pa + wa * na, zb = pb + wb * nbv;
#pragma unroll
            for (int e = 0; e < 4; ++e) ov[4 * h + e] = za[e] * __builtin_amdgcn_rcpf(1.0f + __builtin_amdgcn_exp2f(-1.4426950408889634f * za[e])) * zb[e];
        }
        u32x4 w; w.x = pk2(ov[0], ov[1]); w.y = pk2(ov[2], ov[3]); w.z = pk2(ov[4], ov[5]); w.w = pk2(ov[6], ov[7]);
        *(u32x4*)(ACT + (size_t)row * DFF + f0) = w;
    }
}

__device__ __forceinline__ void phase_actq(LAS unsigned char* lds_) {
    const ArgsP ap = kargs(); Frame F = make_frame(lds_);
    const int gw = F.vcu * 8 + F.wave, NGW = F.G * 8; const bf16* ACT = (const bf16*)(ap->ws + WS_ACT); unsigned char* A8 = ap->ws + WS_ACT8; float* SA = (float*)(ap->ws + WS_SA);
    constexpr int NBLK = DFF / 64;
    bf16x8 HA[8]; hadamard_frags(HA, F.lane);
    LAS unsigned char* hb = F.lds + F.wave * 4096;
    const int fr = F.lane & 15, fq = F.lane >> 4;
    bf16x8 BB[24];
#define AQ_LOADB(ROW, CH) do { _Pragma("unroll") for (int nj = 0; nj < 4; ++nj) { int blk = 64 * (CH) + 16 * nj + fr; blk = blk < NBLK ? blk : NBLK - 1; \
        _Pragma("unroll") for (int ks = 0; ks < 2; ++ks) BB[8 * (CH) + 2 * nj + ks] = *(const bf16x8*)((ROW) + blk * 64 + 32 * ks + 8 * fq); } } while (0)
#define AQ_MMA(CH) do { _Pragma("unroll") for (int mi = 0; mi < 4; ++mi) _Pragma("unroll") for (int nj = 0; nj < 4; ++nj) { f32x4 c = {0.f, 0.f, 0.f, 0.f}; \
        c = __builtin_amdgcn_mfma_f32_16x16x32_bf16(HA[2 * mi], BB[8 * (CH) + 2 * nj], c, 0, 0, 0); c = __builtin_amdgcn_mfma_f32_16x16x32_bf16(HA[2 * mi + 1], BB[8 * (CH) + 2 * nj + 1], c, 0, 0, 0); C[4 * mi + nj] = c; } } while (0)
    if (gw < MROWS) { const bf16* row0 = ACT + (size_t)gw * DFF; AQ_LOADB(row0, 0); AQ_LOADB(row0, 1); AQ_LOADB(row0, 2); }
    for (int m = gw; m < MROWS; m += NGW) {
        const bf16* rown = ACT + (size_t)((m + NGW < MROWS) ? m + NGW : m) * DFF;
        float am = 0.f;
#pragma unroll
        for (int ch = 0; ch < 3; ++ch) { f32x4 C[16]; AQ_MMA(ch);
#pragma unroll
            for (int t = 0; t < 16; ++t) am = fmaxf(fmaxf(am, fmaxf(fabsf(C[t][0]), fabsf(C[t][1]))), fmaxf(fabsf(C[t][2]), fabsf(C[t][3]))); }
#pragma unroll
        for (int o = 1; o < 64; o <<= 1) am = fmaxf(am, __shfl_xor(am, o));
        const float inv = am > 0.f ? 127.0f / am : 0.f;
        if (F.lane == 0) SA[m] = am * (1.0f / 127.0f);
#pragma unroll
        for (int ch = 0; ch < 3; ++ch) { f32x4 C[16]; AQ_MMA(ch);
#pragma unroll
            for (int mi = 0; mi < 4; ++mi)
#pragma unroll
                for (int nj = 0; nj < 4; ++nj) { const f32x4 c = C[4 * mi + nj];
                    *(LAS unsigned*)(hb + (16 * nj + fr) * 64 + 16 * mi + 4 * fq) = pack_q8s<false>(c[0], c[1], c[2], c[3], inv); }
            AQ_LOADB(rown, ch);
            LDS_WAIT();
            const int nbytes = (ch < 2 ? 64 : NBLK - 128) * 64;
#pragma unroll
            for (int q = 0; q < 4; ++q) { const int off = q * 1024 + F.lane * 16; if (off < nbytes) *(u32x4*)(A8 + (size_t)m * DFF + ch * 4096 + off) = *(const LAS u32x4*)(hb + off); }
            LDS_WAIT();
        }
    }
#undef AQ_LOADB
#undef AQ_MMA
}

__device__ __forceinline__ void phase_rows_final(LAS unsigned char* lds_) {
    const ArgsP ap = kargs(); Frame F = make_frame(lds_);
    const float* mod = (const float*)(ap->ws + WS_MOD); const bf16* Y = (const bf16*)(ap->ws + WS_Y); const bf16* H1 = (const bf16*)(ap->ws + WS_U);
    LAS f32x4* VL = (LAS f32x4*)F.lds;
    const int NSTEP = (MROWS / 8 + F.G - 1) / F.G;
    int cur = -1;
    u32x2 yw[16], hw[16];
    { const int mf = F.vcu * NSTEP * 8 + F.wave; if (mf < MROWS) {
#pragma unroll
        for (int j = 0; j < 16; ++j) { yw[j] = *(const u32x2*)(Y + (size_t)mf * DM + 4 * (F.lane + 64 * j)); hw[j] = *(const u32x2*)(H1 + (size_t)mf * DM + 4 * (F.lane + 64 * j)); } } }
    for (int i = 0; i < NSTEP; ++i) {
        const int m0 = (F.vcu * NSTEP + i) * 8; if (m0 >= MROWS) break;
        const int m = m0 + F.wave, sq = seq_of(m0), mnx = (i + 1 < NSTEP && m0 + 8 < MROWS) ? m + 8 : m;
        if (sq != cur) {
            __syncthreads();
            const f32x4* md4 = (const f32x4*)(mod + (size_t)sq * (6 * DM)); const f32x4* gpo = (const f32x4*)ap->g_ffn_post;
            for (int c = F.tid; c < 1024; c += 512) VL[c] = md4[5 * 1024 + c] * gpo[c];
            __syncthreads(); cur = sq;
        }
        f32x4 h[16], r[16]; float s = 0.f;
#pragma unroll
        for (int j = 0; j < 16; ++j) { const u32x2 w = yw[j]; h[j] = (f32x4){bflo(w.x), bfhi(w.x), bflo(w.y), bfhi(w.y)}; const u32x2 q = hw[j]; r[j] = (f32x4){bflo(q.x), bfhi(q.x), bflo(q.y), bfhi(q.y)};
            s += (h[j][0] * h[j][0] + h[j][1] * h[j][1]) + (h[j][2] * h[j][2] + h[j][3] * h[j][3]); }
#pragma unroll
        for (int j = 0; j < 16; ++j) { yw[j] = *(const u32x2*)(Y + (size_t)mnx * DM + 4 * (F.lane + 64 * j)); hw[j] = *(const u32x2*)(H1 + (size_t)mnx * DM + 4 * (F.lane + 64 * j)); }
        const float rstd = 1.0f / sqrtf(wave_sum(s) * (1.0f / DM) + NORM_EPS);
#pragma unroll
        for (int j = 0; j < 16; ++j) { const int c = F.lane + 64 * j; *(f32x4*)(ap->out + (size_t)m * DM + 4 * c) = r[j] + VL[c] * (h[j] * rstd); }
    }
    __syncthreads();
}

constexpr int NPHASE = 12;
__global__ void __launch_bounds__(512, 2) fwd_kernel(Args args) {
    extern __shared__ __attribute__((aligned(16))) unsigned char lds[];
    LAS unsigned char* L = (LAS unsigned char*)lds;
    volatile LAS unsigned* MISC = (volatile LAS unsigned*)(L + LDSCTL_OFF);
    for (int u = threadIdx.x; u < (LDS_BYTES - LDSCTL_OFF) / 4; u += 512) ((LAS unsigned*)(L + LDSCTL_OFF))[u] = 0u;
    __syncthreads();
    XcdBarrier bar; bar.bar = (unsigned*)(args.ws + WS_CTL) + CW_BAR; bar.x = 0; bar.st = nullptr;
#if !MK_PER_PHASE
    bar = xcd_barrier_post((unsigned*)(args.ws + WS_CTL) + CW_BAR, MISC + 8);
#endif
#ifndef PH_MASK
#define PH_MASK 0xffff
#endif
#if MK_PER_PHASE
    const int lo = args.ph_lo, hi = args.ph_hi;
#define IN(k) (((PH_MASK >> (k)) & 1) && lo <= (k) && (k) < hi)
#define SEAM(k) do { } while (0)
#else
#define IN(k) ((PH_MASK >> (k)) & 1)
#define SEAM(k) xcd_barrier(bar)
#endif
    if (IN(0)) { phase0(L); } SEAM(0);
    if (IN(1)) { phase_rows_u(L); } SEAM(1);
    if (IN(2)) {
        const ArgsP ap = kargs(); unsigned char* ws = ap->ws; const int G = gridDim.x; unsigned char* ob = (unsigned char*)ap->out;
        pg8::Gemm g{(const bf16*)(ob + OUT_U8), (const bf16*)(ws + WS_W8), MROWS, NINB, DM / 2}; pg8::StaticOrder S; S.init(MROWS, NINB, G, (int)blockIdx.x);
        pg8::EpiInB E{ws, ap->g_q, ap->g_k, (LAS float*)(L + XS_OFF)};
        pg8::gemm_phase<pg8::EpiInB, pg8::StaticOrder, PG8_ALIGN, PG8_SP2, PG8_BAL>(L, g, S, E);
    } SEAM(2);
    if (IN(3)) {
        v8t_pass(L); __syncthreads();
        const ArgsP ap = kargs(); unsigned char* ws = ap->ws; const int G = gridDim.x;
        pg8::Gemm g{(const bf16*)(ws + WS_U), (const bf16*)(ws + WS_WIN), MROWS, NINA, DM}; pg8::StaticOrder S; S.init(MROWS, NINA, G, (int)blockIdx.x);
        pg8::EpiInA E{(bf16*)(ws + WS_P)};
        pg8::gemm_phase<pg8::EpiInA, pg8::StaticOrder, PG8_ALIGN, PG8_SP2, PG8_BAL>(L, g, S, E);
    } SEAM(3);
    if (IN(4)) {
        const ArgsP ap = kargs(); unsigned char* ws = ap->ws; const int G = gridDim.x;
        const att::Merge mg{(const bf16*)(ws + WS_SGA), (const bf16*)(ws + WS_GBS), (const bf16*)(ws + WS_P), ap->conv_w, ap->conv_b};
        const signed char* Q = (const signed char*)(ws + WS_Q); bf16* MGo = (bf16*)(ws + WS_U); const signed char* Kb = (const signed char*)(ws + WS_K); const unsigned char* Vb = (const unsigned char*)(ws + WS_V8T);
        int atid = threadIdx.x; asm volatile("" : "+v"(atid));
        for (int ui = blockIdx.x; ui < 3072; ui += G) {
            int kvh, qb, gq, seq, seqrow0;
            if (ui < 1024) { kvh = ui & 7; qb = (ui >> 3) & 31; gq = ui >> 8; seq = SEQS; seqrow0 = MP; }
            else { const int p = ui - 1024, loc = (p >> 3) & 31; kvh = p & 7; gq = loc >> 3; qb = loc & 7; seq = SEQP; seqrow0 = (p >> 8) * SEQP; }
            const int h = kvh * 4 + gq; const size_t row0 = (size_t)seqrow0 + (size_t)qb * 256;
            att::attn_unit(Q + row0 * DM + h * 128, MGo + row0 * DM + h * 128, Kb + (size_t)seqrow0 * KVD + kvh * 128, Vb + (size_t)(kvh * (MROWS / 64) + (seqrow0 >> 6)) * 8192, seq, qb * 256, row0, h, mg, (char*)lds, (char*)lds + ATT_SCR_OFF, atid);
        }
    } SEAM(4);
    if (IN(5)) {
        unsigned char* ws = kargs()->ws; const int G = gridDim.x;
        pg8::Gemm g{(const bf16*)(ws + WS_U), (const bf16*)(ws + WS_WO), MROWS, DM, DM}; pg8::StaticOrder S; S.init(MROWS, DM, G, (int)blockIdx.x);
        pg8::EpiBf16 E{(bf16*)(ws + WS_OUT), DM};
        pg8::gemm_phase<pg8::EpiBf16, pg8::StaticOrder, PG8_ALIGN, PG8_SP2, PG8_BAL>(L, g, S, E);
    } SEAM(5);
    if (IN(6)) { phase_rows_mid(L); } SEAM(6);
    if (IN(7)) {
        if (T8 > 0) {
            const ArgsP ap = kargs(); unsigned char* ws = ap->ws; const int G = gridDim.x;
            pg8::Gemm g{(const bf16*)(ws + WS_U28), (const bf16*)(ws + WS_WUP), MROWS, T8 * 256, DM / 2}; pg8::StaticOrder S; S.init(MROWS, T8 * 256, G, (int)blockIdx.x);
            pg8::EpiUp<true> E{(bf16*)(ws + WS_ACT), (float*)(ws + WS_SB), ap->ffn_conv_w, ap->ffn_conv_b, (const float*)(ws + WS_SU2), (const float*)(ws + WS_SWPU), 0};
            pg8::gemm_phase<pg8::EpiUp<true>, pg8::StaticOrder, PG8_ALIGN, PG8_SP2, PG8_BAL, true>(L, g, S, E);
        }
        if (T8 < NT_UP) {
            const ArgsP ap = kargs(); unsigned char* ws = ap->ws; const int G = gridDim.x;
            pg8::Gemm g{(const bf16*)(ws + WS_U), (const bf16*)(ws + WS_WUP) + (size_t)T8 * 256 * DM, MROWS, (NT_UP - T8) * 256, DM}; pg8::StaticOrder S; S.init(MROWS, (NT_UP - T8) * 256, G, (int)blockIdx.x);
            pg8::EpiUp<false> E{(bf16*)(ws + WS_ACT), (float*)(ws + WS_SB), ap->ffn_conv_w, ap->ffn_conv_b, nullptr, nullptr, T8};
            pg8::gemm_phase<pg8::EpiUp<false>, pg8::StaticOrder, PG8_ALIGN, PG8_SP2, PG8_BAL>(L, g, S, E);
        }
        tail_copy_wdown(L, (MROWS / 256) * (T8 < NT_UP ? NT_UP - T8 : T8));
    } SEAM(7);
    if (IN(8)) { phase_fixup(L); } SEAM(8);
    if (IN(9)) { phase_actq(L); } SEAM(9);
    if (IN(10)) {
        unsigned char* ws = kargs()->ws; const int G = gridDim.x;
        pg8::Gemm g{(const bf16*)(ws + WS_ACT8), (const bf16*)(ws + WS_WDN), MROWS, DM, DFF / 2}; pg8::StaticOrder S; S.init(MROWS, DM, G, (int)blockIdx.x);
        pg8::EpiI8Bf16 E{(bf16*)(ws + WS_Y), DM, (const float*)(ws + WS_SA), (const float*)(ws + WS_SWD)};
        pg8::gemm_phase<pg8::EpiI8Bf16, pg8::StaticOrder, PG8_ALIGN, PG8_SP2, PG8_BAL>(L, g, S, E);
    } SEAM(10);
    if (IN(11)) { phase_rows_final(L); }
#undef IN
#undef SEAM
}

extern "C" void kernel_launch(void* const* d_in, const int* in_sizes, int n_in, void* d_out, int out_size, void* d_ws, size_t ws_size, hipStream_t stream) {
    static int grid = 0;
    if (grid == 0) {
        if (n_in != 20 || in_sizes[0] != MP * DM || in_sizes[1] != MS * DM || out_size != MROWS * DM || ws_size < WS_END) {
            fprintf(stderr, "kernel_launch: shape/workspace mismatch: n_in %d in0 %d in1 %d out %d ws %zu (need %zu); nothing launched\n", n_in, n_in > 0 ? in_sizes[0] : -1, n_in > 1 ? in_sizes[1] : -1, out_size, ws_size, (size_t)WS_END); grid = -1; return; }
        int dev = 0, cus = 0, per_cu = 0;
        if (hipGetDevice(&dev) != hipSuccess || hipDeviceGetAttribute(&cus, hipDeviceAttributeMultiprocessorCount, dev) != hipSuccess) { fprintf(stderr, "kernel_launch: device query failed\n"); grid = -1; return; }
        if (hipFuncSetAttribute((const void*)fwd_kernel, hipFuncAttributeMaxDynamicSharedMemorySize, LDS_BYTES) != hipSuccess) { fprintf(stderr, "kernel_launch: hipFuncSetAttribute failed\n"); grid = -1; return; }
        if (hipOccupancyMaxActiveBlocksPerMultiprocessor(&per_cu, (const void*)fwd_kernel, 512, LDS_BYTES) != hipSuccess || per_cu < 1)
            fprintf(stderr, "kernel_launch: note: occupancy query reports %d workgroups per CU\n", per_cu);
        (void)hipGetLastError();
        grid = cus;
    }
    if (grid < 0) return;
    if (hipMemsetAsync((char*)d_ws + WS_CTL, 0, ZERO_BYTES, stream) != hipSuccess) { fprintf(stderr, "kernel_launch: memset failed\n"); return; }
    Args a{};
    const float** pp = (const float**)&a;
    for (int i = 0; i < 20; ++i) pp[i] = (const float*)d_in[i];
    a.out = (float*)d_out; a.ws = (unsigned char*)d_ws;
#if MK_PER_PHASE
    for (int p = 0; p < NPHASE; ++p) { a.ph_lo = p; a.ph_hi = p + 1; hipLaunchKernelGGL(fwd_kernel, dim3(grid), dim3(512), LDS_BYTES, stream, a); }
#else
    a.ph_lo = 0; a.ph_hi = NPHASE; hipLaunchKernelGGL(fwd_kernel, dim3(grid), dim3(512), LDS_BYTES, stream, a);
#endif
    const hipError_t le = hipPeekAtLastError();
    if (le != hipSuccess) fprintf(stderr, "kernel_launch: launch failed: %s\n", hipGetErrorName(le));
}
```
